# Optimizing an MI355X kernel written in HIP

```python
import jax, jax.numpy as jnp
from jax import lax
import numpy as np

D_MODEL = 4096
BATCH = 4
SEQ = 4096
DEPTH = 2

N_MIXERS = 2
EPS = 1e-6
GM_CHUNK = 128
GM_HEADS = 8
GM_WIDTH = D_MODEL
GM_HEAD_DIM = GM_WIDTH // GM_HEADS
ML_HEADS = 8
ML_QK_DIM = D_MODEL // ML_HEADS // 2
ML_V_DIM = D_MODEL // ML_HEADS
ML_CHUNK = 128
GATE_CAP = 15.0
ML_IN = 2 * ML_HEADS * ML_QK_DIM + 2 * ML_HEADS * ML_V_DIM + 2 * ML_HEADS
D_FF = 4 * D_MODEL
N_A = (DEPTH + 1) // 2
N_B = DEPTH // 2

kernel_name = "hybrid_gmlp_mlstm_sqrelu"


def rmsnorm(x, g):
    xf = x.astype(jnp.float32)
    y = xf * lax.rsqrt(jnp.mean(xf * xf, axis=-1, keepdims=True) + EPS)
    return (y * g.astype(jnp.float32)).astype(x.dtype)


def layernorm(x, g, b):
    xf = x.astype(jnp.float32)
    mu = jnp.mean(xf, axis=-1, keepdims=True)
    xc = xf - mu
    y = xc * lax.rsqrt(jnp.mean(xc * xc, axis=-1, keepdims=True) + EPS)
    return (y * g.astype(jnp.float32) + b.astype(jnp.float32)).astype(x.dtype)


def gmlp_mixer(h, w_in, ln_g, ln_b, w_s, b_s, w_out):
    B, S, _ = h.shape
    nc = S // GM_CHUNK
    z = jax.nn.gelu(h @ w_in, approximate=False)
    u, v = jnp.split(z, 2, axis=-1)
    v = layernorm(v, ln_g, ln_b)
    v = v.reshape(B, nc, GM_CHUNK, GM_HEADS, GM_HEAD_DIM)
    causal = jnp.tril(jnp.ones((GM_CHUNK, GM_CHUNK), dtype=bool))
    w = jnp.where(causal[None], w_s, 0).astype(v.dtype)
    mixed = jnp.einsum('hts,bcshd->bcthd', w, v) + b_s.T[:, :, None].astype(v.dtype)
    gated = u * mixed.reshape(B, S, GM_WIDTH)
    return gated @ w_out


def mlstm_mixer(h, w_in, b_gate, head_g, w_out):
    B, S, _ = h.shape
    H, DK, DV, L = ML_HEADS, ML_QK_DIM, ML_V_DIM, ML_CHUNK
    nc = S // L
    f32 = jnp.float32
    proj = h @ w_in
    q, k, v, o, gates = jnp.split(
        proj, [H * DK, 2 * H * DK, 2 * H * DK + H * DV, 2 * H * DK + 2 * H * DV], axis=-1)
    gates = (gates + b_gate).astype(f32)
    gates = GATE_CAP * jnp.tanh(gates / GATE_CAP)
    i_pre = gates[..., :H]
    log_f = jax.nn.log_sigmoid(gates[..., H:])

    def to_chunks(t, d):
        return t.reshape(B, nc, L, H, d).transpose(1, 0, 3, 2, 4).astype(f32)

    qc = to_chunks(q, DK) * (DK ** -0.5)
    kc = to_chunks(k, DK)
    vc = to_chunks(v, DV)
    ic = i_pre.reshape(B, nc, L, H).transpose(1, 0, 3, 2)
    fc = log_f.reshape(B, nc, L, H).transpose(1, 0, 3, 2)
    causal = jnp.tril(jnp.ones((L, L), dtype=bool))

    def step(carry, xs):
        C, n, m = carry
        q_, k_, v_, i_, lf = xs
        bcum = jnp.cumsum(lf, axis=-1)
        g = bcum[..., -1]
        d_log = bcum[..., :, None] - bcum[..., None, :] + i_[..., None, :]
        d_log = jnp.where(causal, d_log, -jnp.inf)
        inter_log = bcum + m[..., None]
        m_t = jnp.maximum(inter_log, jnp.max(d_log, axis=-1))
        dmat = jnp.exp(d_log - m_t[..., None])
        inter_w = jnp.exp(inter_log - m_t)
        s = jnp.einsum('bhtk,bhsk->bhts', q_, k_) * dmat
        num = (inter_w[..., None] * jnp.einsum('bhtk,bhkv->bhtv', q_, C)
               + jnp.einsum('bhts,bhsv->bhtv', s, v_))
        den = inter_w * jnp.einsum('bhtk,bhk->bht', q_, n) + jnp.sum(s, axis=-1)
        h_out = num / jnp.maximum(jnp.abs(den), jnp.exp(-m_t))[..., None]
        a = g[..., None] - bcum + i_
        m_new = jnp.maximum(g + m, jnp.max(a, axis=-1))
        decay = jnp.exp(g + m - m_new)
        kw = k_ * jnp.exp(a - m_new[..., None])[..., None]
        C_new = decay[..., None, None] * C + jnp.einsum('bhsk,bhsv->bhkv', kw, v_)
        n_new = decay[..., None] * n + jnp.sum(kw, axis=2)
        return (C_new, n_new, m_new), h_out

    init = (jnp.zeros((B, H, DK, DV), f32), jnp.zeros((B, H, DK), f32), jnp.zeros((B, H), f32))
    _, hs = lax.scan(step, init, (qc, kc, vc, ic, fc))
    hs = hs.transpose(1, 0, 3, 2, 4).reshape(B, S, H, DV)
    hs = rmsnorm(hs, head_g).astype(h.dtype)
    hs = hs.reshape(B, S, H * DV) * jax.nn.sigmoid(o)
    return hs @ w_out


def sqrelu_mlp(h, w_up, w_down):
    a = jax.nn.relu(h @ w_up)
    return (a * a) @ w_down


def setup_inputs(seed: int = 0) -> dict:
    key = jax.random.key(seed)
    ks = jax.random.split(key, 20)
    nrm = jax.random.normal
    f32 = jnp.float32
    x = nrm(ks[0], (BATCH, SEQ, D_MODEL), f32)
    norm_mix = 1.0 + 0.05 * nrm(ks[1], (DEPTH, D_MODEL), f32)
    norm_ffn = 1.0 + 0.05 * nrm(ks[2], (DEPTH, D_MODEL), f32)
    gm_w_in = nrm(ks[3], (N_A, D_MODEL, 2 * GM_WIDTH), f32) * D_MODEL ** -0.5
    gm_ln_g = 1.0 + 0.05 * nrm(ks[4], (N_A, GM_WIDTH), f32)
    gm_ln_b = 0.02 * nrm(ks[5], (N_A, GM_WIDTH), f32)
    gm_w_s = nrm(ks[6], (N_A, GM_HEADS, GM_CHUNK, GM_CHUNK), f32) * GM_CHUNK ** -0.5
    gm_b_s = 1.0 + 0.05 * nrm(ks[7], (N_A, GM_HEADS, GM_CHUNK), f32)
    gm_w_out = nrm(ks[8], (N_A, GM_WIDTH, D_MODEL), f32) * GM_WIDTH ** -0.5
    ml_w_in = nrm(ks[9], (N_B, D_MODEL, ML_IN), f32) * D_MODEL ** -0.5
    b_i = 0.1 * nrm(ks[10], (N_B, ML_HEADS), f32)
    b_f = 3.0 + 0.5 * nrm(ks[11], (N_B, ML_HEADS), f32)
    ml_b_gate = jnp.concatenate([b_i, b_f], axis=-1)
    ml_head_g = 1.0 + 0.05 * nrm(ks[12], (N_B, ML_HEADS, ML_V_DIM), f32)
    ml_w_out = nrm(ks[13], (N_B, ML_HEADS * ML_V_DIM, D_MODEL), f32) * (ML_HEADS * ML_V_DIM) ** -0.5
    ffn_w_up = nrm(ks[14], (DEPTH, D_MODEL, D_FF), f32) * D_MODEL ** -0.5
    ffn_w_down = nrm(ks[15], (DEPTH, D_FF, D_MODEL), f32) * (0.5 * D_FF ** -0.5)
    norm_final = 1.0 + 0.05 * nrm(ks[16], (D_MODEL,), f32)
    return {"x": x, "norm_mix": norm_mix, "norm_ffn": norm_ffn,
            "gm_w_in": gm_w_in, "gm_ln_g": gm_ln_g, "gm_ln_b": gm_ln_b,
            "gm_w_s": gm_w_s, "gm_b_s": gm_b_s, "gm_w_out": gm_w_out,
            "ml_w_in": ml_w_in, "ml_b_gate": ml_b_gate, "ml_head_g": ml_head_g,
            "ml_w_out": ml_w_out, "ffn_w_up": ffn_w_up, "ffn_w_down": ffn_w_down,
            "norm_final": norm_final}


def reference(x, norm_mix, norm_ffn, gm_w_in, gm_ln_g, gm_ln_b, gm_w_s, gm_b_s, gm_w_out,
              ml_w_in, ml_b_gate, ml_head_g, ml_w_out, ffn_w_up, ffn_w_down, norm_final):
    h = x
    for i in range(DEPTH):
        hn = rmsnorm(h, norm_mix[i])
        j = i // N_MIXERS
        if i % N_MIXERS == 0:
            mix = gmlp_mixer(hn, gm_w_in[j], gm_ln_g[j], gm_ln_b[j], gm_w_s[j], gm_b_s[j], gm_w_out[j])
        else:
            mix = mlstm_mixer(hn, ml_w_in[j], ml_b_gate[j], ml_head_g[j], ml_w_out[j])
        h = h + mix
        h = h + sqrelu_mlp(rmsnorm(h, norm_ffn[i]), ffn_w_up[i], ffn_w_down[i])
    return rmsnorm(h, norm_final)
```

```cpp
#include <hip/hip_runtime.h>
#include <cstdio>
#include <cstdint>
namespace pg8 {
#define PG8_LAS __attribute__((address_space(3)))
typedef unsigned short bf16_t;
typedef short bf16x8 __attribute__((ext_vector_type(8)));
typedef float f32x4 __attribute__((ext_vector_type(4)));
typedef unsigned u32x4 __attribute__((ext_vector_type(4)));
constexpr int BM = 256, BK = 64, HALF = 128, HTB = HALF * BK * 2  , STAGE_BYTES = 8 * HTB, NXCD = 8, WGM = 8;

__host__ __device__ __forceinline__ int lds_byte(int r, int c) { const int st = (r >> 4) * 2 + (c >> 5), rr = r & 15, cc = c & 31, ob = rr * 64 + cc * 2; return st * 1024 + (ob ^ (((ob >> 9) & 1) << 5)); }
__host__ __device__ __forceinline__ void stage_rc(int b, int& R, int& C) { const int st = b / 1024, sb = b % 1024, swz = sb ^ (((sb >> 9) & 1) << 5); R = (st >> 1) * 16 + swz / 64; C = (st & 1) * 32 + (swz % 64) / 2; }
__host__ __device__ __forceinline__ int perm32(int rho) { const int n = rho >> 4, i = rho & 15; return 8 * (i >> 2) + 4 * n + (i & 3); }

struct Unit { int pm, pn; };
struct Gemm { const bf16_t* A; const bf16_t* Bt; int M, N, K; };

struct StaticOrder {
    int nM, nN, nwg, G, c;
    __host__ __device__ void init(int M, int N, int G_, int c_) { nM = M / BM; nN = N / BM; nwg = nM * nN; G = G_; c = c_; }
    __host__ __device__ bool next(int i, Unit& u) const {
        const long L = (long)i * G + c; if (L >= nwg) return false;
        int wgid = (int)L; { const int q = nwg / NXCD, r = nwg % NXCD, xcd = wgid % NXCD, off = wgid / NXCD; wgid = (xcd < r ? xcd * (q + 1) : r * (q + 1) + (xcd - r) * q) + off; }
        const int nig = WGM * nN, gid = wgid / nig, fm = gid * WGM, gsz = (nM - fm) < WGM ? (nM - fm) : WGM;
        u.pm = fm + ((wgid % nig) % gsz); u.pn = (wgid % nig) / gsz; return true;
    }
    __device__ __forceinline__ void a_ready(const Unit&) const {}
    __device__ __forceinline__ void done(const Unit&) const {}
};

struct PanelOrder {
    int pm, pn0, nr;
    __device__ __forceinline__ void init(int N, int c) { pm = ((c & 7) << 3) | ((c >> 3) & 7); pn0 = c >> 6; nr = (N / BM) / 4; }
    __device__ __forceinline__ bool next(int i, Unit& u) const { if (i >= nr) return false; u.pm = pm; u.pn = pn0 + 4 * i; return true; }
    __device__ __forceinline__ void a_ready(const Unit&) const {}
    __device__ __forceinline__ void done(const Unit&) const {}
};

typedef __bf16 bf16x2_native __attribute__((ext_vector_type(2)));
typedef float f32x2_native __attribute__((ext_vector_type(2)));
__device__ __forceinline__ unsigned cvt_pk_bf16_native(float lo, float hi) { const f32x2_native v = {lo, hi}; return __builtin_bit_cast(unsigned, __builtin_convertvector(v, bf16x2_native)); }
__device__ __forceinline__ unsigned cvt_pk_bf16(float lo, float hi) { unsigned r; asm volatile("v_cvt_pk_bf16_f32 %0, %1, %2" : "=v"(r) : "v"(lo), "v"(hi)); return r; }
__device__ __forceinline__ int fresh_tid() { int t = threadIdx.x; asm volatile("" : "+v"(t)); return t; }
#define PG8_FRESH_LANE() const int tz_ = fresh_tid(); const int wid_ = tz_ >> 6, lane_ = tz_ & 63; wr = wid_ >> 2; wc = wid_ & 3; fr = lane_ & 15; fq = lane_ >> 4;
typedef float f32x2 __attribute__((ext_vector_type(2)));
__device__ __forceinline__ f32x2 gelu_pk(f32x2 v) {
    const f32x2 av = __builtin_elementwise_abs(v), d = av * 0.2316418882f + 1.0f;
    f32x2 t; t.x = __builtin_amdgcn_rcpf(d.x); t.y = __builtin_amdgcn_rcpf(d.y);
    f32x2 q = t * 0.5307027145f + (-0.7265760135f); q = q * t + 0.7107068705f; q = q * t + (-0.142248368f); q = q * t + 0.127414796f; q = q * t;
    const f32x2 s = (v * v) * (-0.72134752044f);
    f32x2 e; e.x = __builtin_amdgcn_exp2f(s.x); e.y = __builtin_amdgcn_exp2f(s.y);
    const f32x2 m = v * (q * e), r = v - m;
    f32x2 o; o.x = v.x < 0.f ? m.x : r.x; o.y = v.y < 0.f ? m.y : r.y; return o;
}
__device__ __forceinline__ u32x4 pack8(const f32x4 v0, const f32x4 v1) { u32x4 w; w.x = cvt_pk_bf16(v0[0], v0[1]); w.y = cvt_pk_bf16(v0[2], v0[3]); w.z = cvt_pk_bf16(v1[0], v1[1]); w.w = cvt_pk_bf16(v1[2], v1[3]); return w; }

struct EpiGelu {
    static constexpr bool PERM = true, AFTER_DRAIN = false;
    bf16_t* O; int ldc; f32x2* vstat;
    __device__ __forceinline__ void operator()(const f32x4 (&acc)[2][2][4][2], const Unit& u, int wr, int wc, int fr, int fq) const {
        PG8_FRESH_LANE();
        const int row0 = u.pm * BM + wr * 64 + fr, col0 = u.pn * BM + wc * 32 + 8 * fq;
        const bool st = u.pn >= 16;
#pragma unroll
        for (int ai = 0; ai < 2; ++ai)
#pragma unroll
            for (int m = 0; m < 4; ++m) { const int r = row0 + ai * HALF + m * 16; bf16_t* rowp = O + (size_t)r * ldc + col0; float s1 = 0.f, s2 = 0.f;
#pragma unroll
                for (int bj = 0; bj < 2; ++bj) { f32x4 v0 = acc[ai][bj][m][0], v1 = acc[ai][bj][m][1];
                    const f32x2 a = gelu_pk((f32x2){v0[0], v0[1]}), b = gelu_pk((f32x2){v0[2], v0[3]}), c = gelu_pk((f32x2){v1[0], v1[1]}), d = gelu_pk((f32x2){v1[2], v1[3]});
                    v0 = (f32x4){a.x, a.y, b.x, b.y}; v1 = (f32x4){c.x, c.y, d.x, d.y};
                    s1 += ((v0[0] + v0[1]) + (v0[2] + v0[3])) + ((v1[0] + v1[1]) + (v1[2] + v1[3]));
                    s2 += ((v0[0] * v0[0] + v0[1] * v0[1]) + (v0[2] * v0[2] + v0[3] * v0[3])) + ((v1[0] * v1[0] + v1[1] * v1[1]) + (v1[2] * v1[2] + v1[3] * v1[3]));
                    *(u32x4*)(rowp + bj * HALF) = pack8(v0, v1); }
                s1 += __shfl_xor(s1, 16); s1 += __shfl_xor(s1, 32); s2 += __shfl_xor(s2, 16); s2 += __shfl_xor(s2, 32);
                if (st && fq == 0) vstat[((size_t)r * 16 + (u.pn - 16)) * 4 + wc] = (f32x2){s1, s2}; }
    }
};
template <bool XF32> struct EpiResid {
    static constexpr bool PERM = true, AFTER_DRAIN = false;
    const float* xres; bf16_t* hb; float* hstat;
    __device__ __forceinline__ void operator()(const f32x4 (&acc)[2][2][4][2], const Unit& u, int wr, int wc, int fr, int fq) const {
        PG8_FRESH_LANE();
        const int row0 = u.pm * BM + wr * 64 + fr, col0 = u.pn * BM + wc * 32 + 8 * fq;
#pragma unroll
        for (int g = 0; g < 8; ++g) { const int ai = g >> 2, m = g & 3;
            const int r = row0 + ai * HALF + m * 16; const size_t off = (size_t)r * 4096 + col0; float s2 = 0.f;
            f32x4 r0[2], r1[2];
#pragma unroll
            for (int bj = 0; bj < 2; ++bj) {
                if (XF32) { r0[bj] = *(const f32x4*)(xres + off + bj * HALF); r1[bj] = *(const f32x4*)(xres + off + bj * HALF + 4); }
                else { const u32x4 w = *(const u32x4*)(hb + off + bj * HALF);
                    r0[bj] = (f32x4){__builtin_bit_cast(float, w.x << 16), __builtin_bit_cast(float, w.x & 0xffff0000u), __builtin_bit_cast(float, w.y << 16), __builtin_bit_cast(float, w.y & 0xffff0000u)};
                    r1[bj] = (f32x4){__builtin_bit_cast(float, w.z << 16), __builtin_bit_cast(float, w.z & 0xffff0000u), __builtin_bit_cast(float, w.w << 16), __builtin_bit_cast(float, w.w & 0xffff0000u)}; } }
#pragma unroll
            for (int bj = 0; bj < 2; ++bj) { const f32x4 v0 = acc[ai][bj][m][0] + r0[bj], v1 = acc[ai][bj][m][1] + r1[bj];
                s2 += ((v0[0] * v0[0] + v0[1] * v0[1]) + (v0[2] * v0[2] + v0[3] * v0[3])) + ((v1[0] * v1[0] + v1[1] * v1[1]) + (v1[2] * v1[2] + v1[3] * v1[3]));
                *(u32x4*)(hb + off + bj * HALF) = pack8(v0, v1); }
            s2 += __shfl_xor(s2, 16); s2 += __shfl_xor(s2, 32);
            if (fq == 0) hstat[((size_t)r * 16 + u.pn) * 4 + wc] = s2;
            asm volatile("" ::: "memory"); }
    }
};
template <bool SQ> struct EpiScale {
    static constexpr bool PERM = true, AFTER_DRAIN = false;
    bf16_t* O; int ldc; const PG8_LAS float* rs;
    __device__ __forceinline__ void operator()(const f32x4 (&acc)[2][2][4][2], const Unit& u, int wr, int wc, int fr, int fq) const {
        PG8_FRESH_LANE();
        const int rl0 = wr * 64 + fr, col0 = u.pn * BM + wc * 32 + 8 * fq;
#pragma unroll
        for (int ai = 0; ai < 2; ++ai)
#pragma unroll
            for (int m = 0; m < 4; ++m) { const int rl = rl0 + ai * HALF + m * 16; const float sc = rs[rl]; bf16_t* rowp = O + (size_t)(u.pm * BM + rl) * ldc + col0;
#pragma unroll
                for (int bj = 0; bj < 2; ++bj) { f32x4 v0 = acc[ai][bj][m][0] * sc, v1 = acc[ai][bj][m][1] * sc;
                    if (SQ) {
#pragma unroll
                        for (int j = 0; j < 4; ++j) { const float a = fmaxf(v0[j], 0.f), b = fmaxf(v1[j], 0.f); v0[j] = a * a; v1[j] = b * b; } }
                    *(u32x4*)(rowp + bj * HALF) = pack8(v0, v1); } }
    }
};
template <class Epi, class Sched, bool ALIGN_EPI = false, bool SP2 = false>
__device__ __forceinline__ void gemm_phase(PG8_LAS unsigned char* lds, const Gemm g, const Sched& S, const Epi& E) {
    const int tid = threadIdx.x, wid = __builtin_amdgcn_readfirstlane(tid >> 6), lane = tid & 63, wr = wid >> 2, wc = wid & 3, fr = lane & 15, fq = lane >> 4;
    const int K = g.K, nt = K / BK;
    unsigned voffA[2], voffB[2];
#pragma unroll
    for (int i = 0; i < 2; ++i) { int R, C; stage_rc(tid * 16 + i * 8192, R, C); const int Rb = Epi::PERM ? ((R & ~31) + perm32(R & 31)) : R;
        voffA[i] = (unsigned)(R * K + C) * 2u; voffB[i] = (unsigned)(Rb * K + C) * 2u; }
    const size_t kstep = (size_t)(BK * 2);
    const size_t hstep = (size_t)HALF * K * 2;
    const size_t tstep = 2 * hstep;
    const unsigned ldsw = (unsigned)wid * 1024u;
    const int aoff = lds_byte(wr * 64 + fr, fq * 8), boff = lds_byte(wc * 32 + fr, fq * 8);
#define PG8_SA(b, h) (((b) * 2 + (h)) * HTB)
#define PG8_SB(b, h) ((4 + (b) * 2 + (h)) * HTB)
#define PG8_STAGE(bufoff, gbase, voff) do { _Pragma("unroll") for (int _i = 0; _i < 2; ++_i) \
        __builtin_amdgcn_global_load_lds((const unsigned*)((const char*)(gbase) + (voff)[_i]), (PG8_LAS unsigned*)(lds + (bufoff) + ldsw + _i * 8192), 16, 0, 0); } while (0)
#define PG8_LDA(dst, b, h) do { _Pragma("unroll") for (int m = 0; m < 4; ++m) _Pragma("unroll") for (int k = 0; k < 2; ++k) dst[m][k] = *(const PG8_LAS bf16x8*)(lds + PG8_SA(b, h) + aoff + m * 2048 + k * 1024); } while (0)
#define PG8_LDB(dst, b, h) do { _Pragma("unroll") for (int n = 0; n < 2; ++n) _Pragma("unroll") for (int k = 0; k < 2; ++k) dst[n][k] = *(const PG8_LAS bf16x8*)(lds + PG8_SB(b, h) + boff + n * 2048 + k * 1024); } while (0)
#define PG8_MMA(ai, bj, At, Bt) do { __builtin_amdgcn_s_setprio(1); _Pragma("unroll") for (int m = 0; m < 4; ++m) _Pragma("unroll") for (int n = 0; n < 2; ++n) _Pragma("unroll") for (int k = 0; k < 2; ++k) \
        acc[ai][bj][m][n] = __builtin_amdgcn_mfma_f32_16x16x32_bf16(Bt[n][k], At[m][k], acc[ai][bj][m][n], 0, 0, 0); __builtin_amdgcn_s_setprio(0); } while (0)
#define PG8_WAIT_V(n) asm volatile("s_waitcnt vmcnt(" #n ")" ::: "memory")
#define PG8_WAIT_L(n) asm volatile("s_waitcnt lgkmcnt(" #n ")" ::: "memory")
#define PG8_BAR __builtin_amdgcn_s_barrier()
#define PG8_SCHED __builtin_amdgcn_sched_barrier(0)
    Unit cur, nxt; int ui = 0;
    if (!S.next(0, cur)) return;
    f32x4 acc[2][2][4][2];
#pragma unroll
    for (int a = 0; a < 2; ++a)
#pragma unroll
        for (int b = 0; b < 2; ++b)
#pragma unroll
            for (int m = 0; m < 4; ++m)
#pragma unroll
                for (int n = 0; n < 2; ++n) acc[a][b][m][n] = (f32x4){0.f, 0.f, 0.f, 0.f};
    bf16x8 At[4][2], B0[2][2], B1[2][2];
    const char* cA = (const char*)g.A + (size_t)cur.pm * tstep; const char* cB = (const char*)g.Bt + (size_t)cur.pn * tstep;
    S.a_ready(cur);
    if constexpr (SP2) {
        PG8_STAGE(PG8_SB(0, 0), cB, voffB); PG8_STAGE(PG8_SB(0, 1), cB + hstep, voffB); PG8_STAGE(PG8_SA(0, 0), cA, voffA); PG8_STAGE(PG8_SA(0, 1), cA + hstep, voffA);
        if (wr == 1) PG8_BAR;
        PG8_WAIT_V(2); PG8_BAR;
        PG8_STAGE(PG8_SB(1, 0), cB + kstep, voffB); PG8_STAGE(PG8_SA(1, 0), cA + kstep, voffA); PG8_STAGE(PG8_SB(1, 1), cB + hstep + kstep, voffB);
        PG8_WAIT_V(6); PG8_BAR;
    } else {
        PG8_STAGE(PG8_SB(0, 0), cB, voffB); PG8_STAGE(PG8_SA(0, 0), cA, voffA); PG8_STAGE(PG8_SB(0, 1), cB + hstep, voffB); PG8_STAGE(PG8_SA(0, 1), cA + hstep, voffA);
        if (wr == 1) PG8_BAR;
        PG8_WAIT_V(4); PG8_BAR;
        PG8_STAGE(PG8_SB(1, 0), cB + kstep, voffB); PG8_STAGE(PG8_SA(1, 0), cA + kstep, voffA); PG8_STAGE(PG8_SB(1, 1), cB + hstep + kstep, voffB);
        PG8_WAIT_V(6); PG8_BAR;
    }
    for (;;) {
        const bool has_next = S.next(ui + 1, nxt);
        const char* nA = has_next ? (const char*)g.A + (size_t)nxt.pm * tstep : cA; const char* nB = has_next ? (const char*)g.Bt + (size_t)nxt.pn * tstep : cB;
        for (int t = 0; t < nt; t += 2) {
            const bool last = (t == nt - 2);
            const char* a1 = cA + (size_t)(t + 1) * kstep;
            const char* a2 = last ? nA : cA + (size_t)(t + 2) * kstep; const char* b2 = last ? nB : cB + (size_t)(t + 2) * kstep;
            const char* a3 = a2 + kstep; const char* b3 = b2 + kstep;
            if (last && has_next) S.a_ready(nxt);
            if constexpr (SP2) {
            PG8_LDB(B0, 0, 0); PG8_LDB(B1, 0, 1); PG8_SCHED; PG8_LDA(At, 0, 0); PG8_STAGE(PG8_SA(1, 1), a1 + hstep, voffA);
            PG8_WAIT_V(8); PG8_WAIT_L(0); PG8_BAR; PG8_MMA(0, 0, At, B0); PG8_MMA(0, 1, At, B1); PG8_BAR; PG8_SCHED;
            PG8_LDA(At, 0, 1); PG8_STAGE(PG8_SB(0, 0), b2, voffB); PG8_STAGE(PG8_SB(0, 1), b2 + hstep, voffB); PG8_STAGE(PG8_SA(0, 0), a2, voffA);
            PG8_WAIT_V(8); PG8_WAIT_L(0); PG8_BAR; PG8_MMA(1, 0, At, B0); PG8_MMA(1, 1, At, B1); PG8_BAR; PG8_SCHED;
            PG8_LDB(B0, 1, 0); PG8_LDB(B1, 1, 1); PG8_SCHED; PG8_LDA(At, 1, 0); PG8_STAGE(PG8_SA(0, 1), a2 + hstep, voffA);
            PG8_WAIT_V(8); PG8_WAIT_L(0); PG8_BAR; PG8_MMA(0, 0, At, B0); PG8_MMA(0, 1, At, B1); PG8_BAR; PG8_SCHED;
            PG8_LDA(At, 1, 1); PG8_STAGE(PG8_SB(1, 0), b3, voffB); PG8_STAGE(PG8_SB(1, 1), b3 + hstep, voffB); PG8_STAGE(PG8_SA(1, 0), a3, voffA);
            PG8_WAIT_V(8); PG8_WAIT_L(0); PG8_BAR; PG8_MMA(1, 0, At, B0); PG8_MMA(1, 1, At, B1); PG8_BAR; PG8_SCHED;
            } else {
            PG8_LDB(B0, 0, 0); PG8_SCHED; PG8_LDA(At, 0, 0); PG8_STAGE(PG8_SA(1, 1), a1 + hstep, voffA);
            PG8_WAIT_L(8); PG8_BAR; PG8_WAIT_L(0); PG8_MMA(0, 0, At, B0); PG8_BAR; PG8_SCHED;
            PG8_LDB(B1, 0, 1); PG8_STAGE(PG8_SB(0, 0), b2, voffB);
            PG8_BAR; PG8_WAIT_L(0); PG8_MMA(0, 1, At, B1); PG8_BAR;
            PG8_LDA(At, 0, 1); PG8_STAGE(PG8_SA(0, 0), a2, voffA);
            PG8_BAR; PG8_WAIT_L(0); PG8_MMA(1, 0, At, B0); PG8_BAR; PG8_SCHED;
            PG8_STAGE(PG8_SB(0, 1), b2 + hstep, voffB);
            PG8_WAIT_V(6); PG8_BAR; PG8_MMA(1, 1, At, B1); PG8_BAR;
            PG8_LDB(B0, 1, 0); PG8_SCHED; PG8_LDA(At, 1, 0); PG8_STAGE(PG8_SA(0, 1), a2 + hstep, voffA);
            PG8_WAIT_L(8); PG8_BAR; PG8_WAIT_L(0); PG8_MMA(0, 0, At, B0); PG8_BAR; PG8_SCHED;
            PG8_LDB(B1, 1, 1); PG8_STAGE(PG8_SB(1, 0), b3, voffB);
            PG8_BAR; PG8_WAIT_L(0); PG8_MMA(0, 1, At, B1); PG8_BAR;
            PG8_LDA(At, 1, 1); PG8_STAGE(PG8_SA(1, 0), a3, voffA);
            PG8_BAR; PG8_WAIT_L(0); PG8_MMA(1, 0, At, B0); PG8_BAR; PG8_SCHED;
            PG8_STAGE(PG8_SB(1, 1), b3 + hstep, voffB);
            PG8_WAIT_V(6); PG8_BAR; PG8_MMA(1, 1, At, B1); PG8_BAR;
            }
        }
        if constexpr (ALIGN_EPI) { if (wr == 0) PG8_BAR; }
        if constexpr (!Epi::AFTER_DRAIN) { E(acc, cur, wr, wc, fr, fq); S.done(cur); }
        if (!has_next) break;
#pragma unroll
        for (int a = 0; a < 2; ++a)
#pragma unroll
            for (int b = 0; b < 2; ++b)
#pragma unroll
                for (int m = 0; m < 4; ++m)
#pragma unroll
                    for (int n = 0; n < 2; ++n) acc[a][b][m][n] = (f32x4){0.f, 0.f, 0.f, 0.f};
        cur = nxt; cA = nA; cB = nB; ++ui;
        if constexpr (ALIGN_EPI) { if (wr == 1) PG8_BAR; }
    }
    PG8_WAIT_V(0);
    if constexpr (!ALIGN_EPI) { if (wr == 0) PG8_BAR; }
    PG8_BAR;
    if constexpr (Epi::AFTER_DRAIN) { E.fused(acc, cur, wr, wc, fr, fq, lds, wid, lane); S.done(cur); }
#undef PG8_SA
#undef PG8_SB
#undef PG8_STAGE
#undef PG8_LDA
#undef PG8_LDB
#undef PG8_MMA
#undef PG8_WAIT_V
#undef PG8_WAIT_L
#undef PG8_BAR
#undef PG8_SCHED
}
}

constexpr int NWAVES = 8;
constexpr int BATCH = 4, SEQ = 4096, D = 4096, M = BATCH * SEQ, FF = 4 * D;
constexpr int NZ = 2 * D;
constexpr int HEADS = 8, DK = 256, DV = 512, CH = 128, NCH = SEQ / CH;
constexpr int NP = 2 * HEADS * DK + 2 * HEADS * DV;
constexpr int ML_IN = NP + 2 * HEADS;
constexpr float EPS = 1e-6f;
constexpr float GATE_CAP = 15.0f;
#ifndef MK_N_LAUNCHES
#define MK_N_LAUNCHES 1
#endif
constexpr int N_PHASES = 13;

constexpr size_t MiB = 1u << 20;
constexpr size_t WS_CTL = 0, CTL_ZERO_BYTES = 1 * MiB;
constexpr size_t WS_VSTAT = 1 * MiB;
constexpr size_t WS_HSTAT = 9 * MiB;
constexpr size_t WS_HSSTAT = 13 * MiB;
constexpr size_t WS_GATES = 17 * MiB;
constexpr size_t WS_W1 = 32 * MiB;
constexpr size_t WS_W2 = 96 * MiB;
constexpr size_t WS_WUP0 = 128 * MiB;
constexpr size_t WS_WDN0 = 256 * MiB;
constexpr size_t WS_WML = 384 * MiB;
constexpr size_t WS_WMO = 481 * MiB;
constexpr size_t WS_WUP1 = 513 * MiB;
constexpr size_t WS_WDN1 = 641 * MiB;
constexpr size_t WS_HB = 769 * MiB;
constexpr size_t WS_R = 897 * MiB;
constexpr size_t WS_XB = WS_R, WS_Z = WS_R + 128 * MiB, WS_GATED = WS_R + 384 * MiB;
constexpr size_t WS_A = WS_R;
constexpr size_t WS_PROJ = WS_R, WS_HS = WS_R + 384 * MiB;
constexpr size_t WS_END = WS_R + 512 * MiB;
static_assert(WS_WML + (size_t)ML_IN * D * 2 <= WS_WMO, "ws map");
constexpr int CW_BAR = 4096;

constexpr int RING_BYTES = 131072;
constexpr int RS_OFF = RING_BYTES;
constexpr int LDS_BYTES = 147456;
constexpr int MISC_OFF = LDS_BYTES - 256;

#define LAS __attribute__((address_space(3)))
typedef unsigned short bf16;
typedef unsigned v4u __attribute__((ext_vector_type(4)));
typedef unsigned v2u __attribute__((ext_vector_type(2)));
typedef float f32x4 __attribute__((ext_vector_type(4)));
typedef float f32x2 __attribute__((ext_vector_type(2)));
typedef short bf16x8 __attribute__((ext_vector_type(8)));
typedef short s16x4 __attribute__((ext_vector_type(4)));
#define LDS_WAIT() asm volatile("s_waitcnt lgkmcnt(0)" ::: "memory")
__device__ __forceinline__ unsigned f2bf(float f) { unsigned u = __builtin_bit_cast(unsigned, f); return (u + 0x7fffu + ((u >> 16) & 1u)) >> 16; }
__device__ __forceinline__ unsigned pk2(float lo, float hi) { return pg8::cvt_pk_bf16(lo, hi); }
__device__ __forceinline__ unsigned pk2n(float lo, float hi) { return pg8::cvt_pk_bf16_native(lo, hi); }
__device__ __forceinline__ float bf_lo(unsigned u) { return __builtin_bit_cast(float, u << 16); }
__device__ __forceinline__ float bf_hi(unsigned u) { return __builtin_bit_cast(float, u & 0xffff0000u); }
__device__ __forceinline__ float wave_sum(float v) {
#pragma unroll
    for (int o = 1; o < 64; o <<= 1) v += __shfl_xor(v, o);
    return v;
}
#define XB_TMO      128
#define XB_XCNT(j)  (256  + 64 * (j))
#define XB_XSUB(j)  (1280 + 64 * (j))
#define XB_XGEN(j)  (2304 + 64 * (j))
#define XB_TOP      3328
#define XB_TOPGEN   3392
#define XCD_BAR_WORDS 3456
#define XB_SPIN_CAP (1u << 18)

__device__ __forceinline__ unsigned xb_ld(unsigned* p)              { return __hip_atomic_load(p, __ATOMIC_RELAXED, __HIP_MEMORY_SCOPE_AGENT); }
__device__ __forceinline__ unsigned xb_add(unsigned* p, unsigned v) { return __hip_atomic_fetch_add(p, v, __ATOMIC_RELAXED, __HIP_MEMORY_SCOPE_AGENT); }
__device__ __forceinline__ unsigned xb_xcc_id() { return (unsigned)__builtin_amdgcn_s_getreg((3 << 11) | 20) & 0xFu; }
#define XB_SPIN(cond, bar) do { unsigned _sp = 0; while (cond) { __builtin_amdgcn_s_sleep(1); \
    if ((++_sp & 255u) == 0u) { if (xb_ld(&(bar)[XB_TMO])) break; if (_sp > XB_SPIN_CAP) { atomicAdd(&(bar)[XB_TMO], 1u); break; } } } } while (0)

struct XcdBarrier {
    unsigned* bar; unsigned x;
    volatile LAS unsigned* st;
};

__device__ __forceinline__ XcdBarrier xcd_barrier_post(unsigned* bar, volatile LAS unsigned* st) {
    XcdBarrier b; b.bar = bar; b.x = xb_xcc_id(); b.st = st;
    if (threadIdx.x == 0) (void)xb_add(&bar[XB_XCNT(b.x)], 1u);
    return b;
}
__device__ __forceinline__ void xcd_barrier_complete(unsigned* bar, unsigned x, unsigned& nloc, unsigned& nx) {
    const unsigned G = gridDim.x * gridDim.y * gridDim.z;
    unsigned sum, cnt, mine, sp = 0u;
    for (;;) {
        sum = 0u; cnt = 0u; mine = 0u;
#pragma unroll
        for (unsigned j = 0; j < 16; ++j) { const unsigned c = xb_ld(&bar[XB_XCNT(j)]); sum += c; cnt += (c > 0u) ? 1u : 0u; mine = (j == x) ? c : mine; }
        if (sum == G) break;
        __builtin_amdgcn_s_sleep(1);
        if ((++sp & 255u) == 0u) { if (xb_ld(&bar[XB_TMO])) break; if (sp > XB_SPIN_CAP) { atomicAdd(&bar[XB_TMO], 1u); break; } }
    }
    nloc = mine > 0u ? mine : 1u; nx = cnt > 0u ? cnt : 1u;
}

__device__ __forceinline__ void xcd_barrier(const XcdBarrier& b) {
    asm volatile("s_waitcnt vmcnt(0)" ::: "memory");
    __syncthreads();
    if (threadIdx.x == 0) {
        unsigned* bar = b.bar;
        __builtin_amdgcn_s_waitcnt(0);
        unsigned nloc = b.st[0], nx = b.st[1];
        if (nloc == 0u) { xcd_barrier_complete(bar, b.x, nloc, nx); b.st[0] = nloc; b.st[1] = nx; }
        const unsigned old = xb_add(&bar[XB_XSUB(b.x)], 1u);
        const unsigned gen = old / nloc;
        if (old + 1u == (gen + 1u) * nloc) {
            __builtin_amdgcn_fence(__ATOMIC_RELEASE, "agent");
            asm volatile("s_waitcnt vmcnt(0)" ::: "memory");
            const unsigned og = xb_add(&bar[XB_TOP], 1u);
            const unsigned tg = og / nx;
            if (og + 1u == (tg + 1u) * nx) xb_add(&bar[XB_TOPGEN], 1u);
            else XB_SPIN(xb_ld(&bar[XB_TOPGEN]) == tg, bar);
            __builtin_amdgcn_fence(__ATOMIC_ACQUIRE, "agent");
            xb_add(&bar[XB_XGEN(b.x)], 1u);
            asm volatile("s_waitcnt vmcnt(0)" ::: "memory");
        } else {
            XB_SPIN(xb_ld(&bar[XB_XGEN(b.x)]) == gen, bar);
            __builtin_amdgcn_fence(__ATOMIC_ACQUIRE, "agent");
            asm volatile("s_waitcnt vmcnt(0)" ::: "memory");
        }
    }
    __syncthreads();
}

__device__ __forceinline__ void p0_transpose_item(const float* __restrict__ W, int Nsrc, int K, int k0, int n0, int ncols, const float* __restrict__ gk, float cs,
                                                  bf16* __restrict__ WT, LAS float* scr, int lane) {
    const int nq = lane & 15, kh = lane >> 4;
    const bool okc = 4 * nq < ncols;
    f32x4 v[16];
    const float* src = W + (size_t)(k0 + kh) * Nsrc + n0 + 4 * nq;
#pragma unroll
    for (int i = 0; i < 16; ++i) v[i] = okc ? *(const f32x4*)(src + (size_t)(4 * i) * Nsrc) : (f32x4){0.f, 0.f, 0.f, 0.f};
    const int c = lane & 7;
    f32x4 g0 = {cs, cs, cs, cs}, g1 = {cs, cs, cs, cs};
    if (gk) { g0 = *(const f32x4*)(gk + k0 + 8 * c) * cs; g1 = *(const f32x4*)(gk + k0 + 8 * c + 4) * cs; }
#pragma unroll
    for (int i = 0; i < 16; ++i) { const int kk = 4 * i + kh; *(LAS f32x4*)(scr + kk * 64 + ((4 * nq) ^ (4 * ((kk >> 3) & 7)))) = v[i]; }
    LDS_WAIT(); asm volatile("" ::: "memory");
#pragma unroll
    for (int j = 0; j < 8; ++j) { const int n = (lane >> 3) + 8 * j; const LAS float* sp = scr + (8 * c) * 64 + (n ^ (4 * c));
        v4u o; o.x = pk2(sp[0 * 64] * g0.x, sp[1 * 64] * g0.y); o.y = pk2(sp[2 * 64] * g0.z, sp[3 * 64] * g0.w); o.z = pk2(sp[4 * 64] * g1.x, sp[5 * 64] * g1.y); o.w = pk2(sp[6 * 64] * g1.z, sp[7 * 64] * g1.w);
        if (n < ncols) *(v4u*)(WT + (size_t)(n0 + n) * K + k0 + 8 * c) = o; }
    LDS_WAIT(); asm volatile("" ::: "memory");
}
struct WConv { const float* W; const float* gk; bf16* WT; int K, Nsrc; };
__device__ __forceinline__ void p0_convert(const WConv& w, int item, LAS float* scr, int lane, int qcols) {
    const int nnb = (w.Nsrc + 63) / 64, kb = item / nnb, nb = item - kb * nnb, n0 = nb * 64;
    const int ncols = (w.Nsrc - n0) < 64 ? (w.Nsrc - n0) : 64;
    p0_transpose_item(w.W, w.Nsrc, w.K, kb * 64, n0, ncols, w.gk, n0 < qcols ? 0.0625f : 1.0f, w.WT, scr, lane);
}
__device__ __forceinline__ void p0_xrow(const float* __restrict__ xrow, const float* __restrict__ g, bf16* __restrict__ orow, int lane) {
    const f32x4* xr = (const f32x4*)xrow + lane; const f32x4* gr = (const f32x4*)g + lane;
    f32x4 v[16]; float s = 0.f;
#pragma unroll
    for (int j = 0; j < 16; ++j) { v[j] = xr[64 * j]; s += (v[j].x * v[j].x + v[j].y * v[j].y) + (v[j].z * v[j].z + v[j].w * v[j].w); }
    const float rstd = 1.0f / sqrtf(wave_sum(s) * (1.f / D) + EPS);
    v2u* o8 = (v2u*)orow + lane;
#pragma unroll
    for (int j = 0; j < 16; ++j) { const f32x4 gg = gr[64 * j]; v2u o; o.x = pk2(v[j].x * rstd * gg.x, v[j].y * rstd * gg.y); o.y = pk2(v[j].z * rstd * gg.z, v[j].w * rstd * gg.w); o8[64 * j] = o; }
}

__device__ __forceinline__ void load_rstd_table(LAS float* rs, const float* __restrict__ hstat, int pm, int tid) {
    const int row = tid >> 1, half = tid & 1;
    const f32x4* p = (const f32x4*)(hstat + ((size_t)(pm * 256 + row) * 64 + half * 32));
    float s = 0.f;
#pragma unroll
    for (int j = 0; j < 8; ++j) { const f32x4 v = p[j]; s += (v.x + v.y) + (v.z + v.w); }
    s += __shfl_xor(s, 1);
    if (half == 0) rs[row] = 1.0f / sqrtf(s * (1.f / D) + EPS);
    LDS_WAIT(); __syncthreads();
}

__device__ __forceinline__ int img_off(int row, int ch) { return 256 * row + 16 * (ch ^ (((row & 3) << 2) | ((row >> 2) & 3))); }
__device__ __forceinline__ void p2_spatial(LAS unsigned char* lds, const bf16* __restrict__ z, const f32x2* __restrict__ vstat, const float* __restrict__ lng, const float* __restrict__ lnb,
                                           const float* __restrict__ ws_, const float* __restrict__ bs_, bf16* __restrict__ gated, int c, int tid0) {
    LAS unsigned char* Wimg = lds;
    LAS unsigned char* Vimg = lds + 32768;
    LAS float* mu = (LAS float*)(lds + 131072);
    LAS float* rsd = mu + 256;
    const int pm = ((c & 7) << 3) | ((c >> 3) & 7), sub = c >> 6;
    const int w = __builtin_amdgcn_readfirstlane(tid0 >> 6), jq = w & 3, th = w >> 2;
    __syncthreads();
    { const int row = tid0 >> 1, part = tid0 & 1;
      const f32x4* p = (const f32x4*)(vstat + ((size_t)(pm * 256 + row) * 64 + part * 32));
      float s1 = 0.f, s2 = 0.f;
#pragma unroll
      for (int j = 0; j < 16; ++j) { const f32x4 v = p[j]; s1 += v.x + v.z; s2 += v.y + v.w; }
      s1 += __shfl_xor(s1, 1); s2 += __shfl_xor(s2, 1);
      const float mean = s1 * (1.f / D); const float var = fmaxf(s2 * (1.f / D) - mean * mean, 0.f);
      if (part == 0) { mu[row] = mean; rsd[row] = 1.0f / sqrtf(var + EPS); } }
    v4u raw[8];
#define P2_LOADV(STEP) do { const int hi_ = (STEP) >> 2, cc_ = ((STEP) >> 1) & 1, hf_ = (STEP) & 1; const int tp = pg8::fresh_tid(); \
        const bf16* vp_ = z + (size_t)(pm * 256 + cc_ * 128 + (tp >> 5)) * NZ + D + (2 * sub + hi_) * 512 + hf_ * 256 + 8 * (tp & 31); \
        _Pragma("unroll") for (int it = 0; it < 8; ++it) raw[it] = *(const v4u*)(vp_ + (size_t)(16 * it) * NZ); } while (0)
    P2_LOADV(0);
    for (int step = 0; step < 8; ++step) {
        const int hi = step >> 2, cc = (step >> 1) & 1, hf = step & 1, hh = 2 * sub + hi;
        const int m0 = pm * 256 + cc * 128, j0 = hh * 512 + hf * 256;
        __syncthreads();
        if ((step & 3) == 0) { const int tid = pg8::fresh_tid();
#pragma unroll
          for (int it = 0; it < 4; ++it) { const int p = tid + 512 * it, t = p >> 4, ch = p & 15, s0 = 8 * ch;
              const f32x4 a = *(const f32x4*)(ws_ + ((size_t)hh * 128 + t) * 128 + s0), b = *(const f32x4*)(ws_ + ((size_t)hh * 128 + t) * 128 + s0 + 4);
              v4u o; o.x = pk2(s0 + 0 <= t ? a.x : 0.f, s0 + 1 <= t ? a.y : 0.f); o.y = pk2(s0 + 2 <= t ? a.z : 0.f, s0 + 3 <= t ? a.w : 0.f);
              o.z = pk2(s0 + 4 <= t ? b.x : 0.f, s0 + 5 <= t ? b.y : 0.f); o.w = pk2(s0 + 6 <= t ? b.z : 0.f, s0 + 7 <= t ? b.w : 0.f);
              *(LAS v4u*)(Wimg + img_off(t, ch)) = o; } }
        { const int tid = pg8::fresh_tid();
          const int cg = tid & 31; float g8[8], b8[8];
          { const f32x4 a = *(const f32x4*)(lng + j0 + 8 * cg), b = *(const f32x4*)(lng + j0 + 8 * cg + 4); g8[0] = a.x; g8[1] = a.y; g8[2] = a.z; g8[3] = a.w; g8[4] = b.x; g8[5] = b.y; g8[6] = b.z; g8[7] = b.w; }
          { const f32x4 a = *(const f32x4*)(lnb + j0 + 8 * cg), b = *(const f32x4*)(lnb + j0 + 8 * cg + 4); b8[0] = a.x; b8[1] = a.y; b8[2] = a.z; b8[3] = a.w; b8[4] = b.x; b8[5] = b.y; b8[6] = b.z; b8[7] = b.w; }
#pragma unroll
          for (int it = 0; it < 8; ++it) { const int sr = (tid >> 5) + 16 * it; const float mm = mu[cc * 128 + sr], rr = rsd[cc * 128 + sr];
              float f[8] = {bf_lo(raw[it].x), bf_hi(raw[it].x), bf_lo(raw[it].y), bf_hi(raw[it].y), bf_lo(raw[it].z), bf_hi(raw[it].z), bf_lo(raw[it].w), bf_hi(raw[it].w)};
#pragma unroll
              for (int e = 0; e < 8; ++e) f[e] = (f[e] - mm) * rr * g8[e] + b8[e];
              v4u o; o.x = pk2(f[0], f[1]); o.y = pk2(f[2], f[3]); o.z = pk2(f[4], f[5]); o.w = pk2(f[6], f[7]);
              *(LAS v4u*)(Vimg + ((cg >> 4) << 15) + img_off(sr, cg & 15)) = o; } }
        LDS_WAIT(); __syncthreads();
        if (step + 1 < 8) P2_LOADV(step + 1);
        const int tid = pg8::fresh_tid(), lane = tid & 63, l15 = lane & 15, q = lane >> 4;
        const int nks = 2 * th + 2;
        v2u uu[4][4]; float bsv[4];
#pragma unroll
        for (int tbq = 0; tbq < 4; ++tbq) { const int t = 16 * (4 * th + tbq) + l15; bsv[tbq] = bs_[hh * 128 + t];
#pragma unroll
            for (int jb = 0; jb < 4; ++jb) uu[jb][tbq] = *(const v2u*)(z + (size_t)(m0 + t) * NZ + j0 + 64 * jq + 16 * jb + 4 * q); }
#pragma unroll
        for (int jb = 0; jb < 4; ++jb) {
            const int jbl = 4 * jq + jb, cI = jbl & 7; const LAS unsigned char* vb = Vimg + ((jbl >> 3) << 15);
            bf16x8 Af[4];
#pragma unroll
            for (int ks = 0; ks < 4; ++ks) { if (ks < nks) {
                const int r0 = 32 * ks + 8 * q + (l15 >> 2), c8 = 2 * cI + ((l15 & 3) >> 1);
                const s16x4 t0 = __builtin_amdgcn_ds_read_tr16_b64_v4i16((LAS s16x4*)(vb + img_off(r0, c8) + 8 * (l15 & 1)));
                const s16x4 t1 = __builtin_amdgcn_ds_read_tr16_b64_v4i16((LAS s16x4*)(vb + img_off(r0 + 4, c8) + 8 * (l15 & 1)));
                Af[ks] = (bf16x8){t0[0], t0[1], t0[2], t0[3], t1[0], t1[1], t1[2], t1[3]}; } else Af[ks] = (bf16x8){0, 0, 0, 0, 0, 0, 0, 0}; }
#pragma unroll
            for (int tbq = 0; tbq < 4; ++tbq) {
                const int tb = 4 * th + tbq; f32x4 acc = {0.f, 0.f, 0.f, 0.f};
#pragma unroll
                for (int ks = 0; ks < 4; ++ks) if (2 * ks <= tb) { const bf16x8 bfr = *(const LAS bf16x8*)(Wimg + img_off(16 * tb + l15, 4 * ks + q));
                    acc = __builtin_amdgcn_mfma_f32_16x16x32_bf16(Af[ks], bfr, acc, 0, 0, 0); }
                const int t = 16 * tb + l15, j = j0 + 64 * jq + 16 * jb + 4 * q; const float bb = bsv[tbq]; const v2u u2 = uu[jb][tbq];
                v2u o; o.x = pk2n(bf_lo(u2.x) * (acc[0] + bb), bf_hi(u2.x) * (acc[1] + bb)); o.y = pk2n(bf_lo(u2.y) * (acc[2] + bb), bf_hi(u2.y) * (acc[3] + bb));
                *(v2u*)(gated + (size_t)(m0 + t) * D + j) = o;
            }
        }
    }
#undef P2_LOADV
}

__device__ __forceinline__ void p6_gates(const bf16* __restrict__ hb, const bf16* __restrict__ wg, const LAS float* rs, float* __restrict__ gates, int c, int wave, int lane) {
    if (wave >= 4) return;
    const int pm = ((c & 7) << 3) | ((c >> 3) & 7), sub = c >> 6;
    const int rl0 = 64 * sub + 16 * wave, l15 = lane & 15, q = lane >> 4;
    const bf16* ap = hb + (size_t)(pm * 256 + rl0 + l15) * D + 8 * q;
    const bf16* bp = wg + (size_t)l15 * D + 8 * q;
    f32x4 acc0 = {0.f, 0.f, 0.f, 0.f}, acc1 = {0.f, 0.f, 0.f, 0.f};
#pragma unroll 4
    for (int ks = 0; ks < D / 32; ks += 2) {
        const bf16x8 a0 = *(const bf16x8*)(ap + 32 * ks), b0 = *(const bf16x8*)(bp + 32 * ks);
        const bf16x8 a1 = *(const bf16x8*)(ap + 32 * ks + 32), b1 = *(const bf16x8*)(bp + 32 * ks + 32);
        acc0 = __builtin_amdgcn_mfma_f32_16x16x32_bf16(a0, b0, acc0, 0, 0, 0);
        acc1 = __builtin_amdgcn_mfma_f32_16x16x32_bf16(a1, b1, acc1, 0, 0, 0);
    }
#pragma unroll
    for (int r = 0; r < 4; ++r) { const int rl = rl0 + 4 * q + r; gates[(size_t)(pm * 256 + rl) * 16 + l15] = (acc0[r] + acc1[r]) * rs[rl]; }
}

constexpr int P7_KS = 528, P7_VS = 272, P7_K_OFF = 0, P7_VT_OFF = 65536, P7_CT_OFF = P7_VT_OFF + 80 * P7_VS, P7_VEC_OFF = P7_CT_OFF + 80 * P7_KS;
__device__ __forceinline__ int p7_koff(int row, int dk8  ) { const int ch = dk8 & 15; return ((dk8 >> 4) << 15) + 256 * row + 16 * (ch ^ (((row & 3) << 2) | ((row >> 2) & 3))); }
static_assert(P7_VEC_OFF + 4096 <= MISC_OFF && P7_VT_OFF % 16 == 0 && P7_CT_OFF % 16 == 0 && P7_VEC_OFF % 16 == 0, "P7 LDS map");
__device__ __forceinline__ void p7_mlstm(LAS unsigned char* lds, const bf16* __restrict__ proj, const float* __restrict__ gates, const float* __restrict__ bgate,
                                         bf16* __restrict__ hs, float* __restrict__ hsstat, float* __restrict__ gsc  , int c, int tid0) {
    const int w = __builtin_amdgcn_readfirstlane(tid0 >> 6);
    const int tb = w < 4 ? w : 11 - w;
    const int xcd = c & 7, y = c >> 3, bh = 8 * (y >> 3) + xcd, sl = y & 7, b = bh >> 3, h = bh & 7;
    LAS unsigned char* Kl = lds + P7_K_OFF; LAS unsigned char* VT = lds + P7_VT_OFF; LAS unsigned char* CT = lds + P7_CT_OFF;
    LAS float* ve = (LAS float*)(lds + P7_VEC_OFF);
    LAS float* vM = ve + 128, *viw = ve + 256, *vfl = ve + 384, *vw = ve + 512, *vsc = ve + 640;
    __syncthreads();
    for (int i = tid0; i < 80 * P7_KS / 4; i += 512) ((LAS unsigned*)CT)[i] = 0u;
    for (int i = tid0; i < 16 * P7_VS / 4; i += 512) ((LAS unsigned*)(VT + 64 * P7_VS))[i] = (i < P7_VS / 4) ? 0x3f803f80u : 0u;
    { const float bi = bgate[h], bfg = bgate[8 + h]; const int lane = tid0 & 63, t0 = 2 * lane;
      for (int ch = w; ch < NCH; ch += 8) { const int m0 = b * SEQ + ch * CH;
          float ip[2], lf[2];
#pragma unroll
          for (int k = 0; k < 2; ++k) { const float gi = gates[(size_t)(m0 + t0 + k) * 16 + h] + bi, gf = gates[(size_t)(m0 + t0 + k) * 16 + 8 + h] + bfg;
              ip[k] = GATE_CAP * tanhf(gi * (1.f / GATE_CAP)); const float fp = GATE_CAP * tanhf(gf * (1.f / GATE_CAP));
              lf[k] = fminf(fp, 0.f) - log1pf(expf(-fabsf(fp))); }
          const float pair = lf[0] + lf[1]; float inc = pair;
#pragma unroll
          for (int o = 1; o < 64; o <<= 1) { const float n = __shfl_up(inc, o); if (lane >= o) inc += n; }
          const float bc0 = (inc - pair) + lf[0], bc1 = inc;
          const float e0 = ip[0] - bc0, e1 = ip[1] - bc1;
          float im = fmaxf(e0, e1);
#pragma unroll
          for (int o = 1; o < 64; o <<= 1) { const float n = __shfl_up(im, o); if (lane >= o) im = fmaxf(im, n); }
          float ex = __shfl_up(im, 1); if (lane == 0) ex = -3.0e38f;
          f32x2* g2 = (f32x2*)(gsc + ch * 384) + lane;
          g2[0] = (f32x2){bc0, bc1}; g2[64] = (f32x2){e0, e1}; g2[128] = (f32x2){fmaxf(ex, e0), im}; } }
    f32x4 accC[2][5];
#pragma unroll
    for (int a = 0; a < 2; ++a)
#pragma unroll
        for (int d = 0; d < 5; ++d) accC[a][d] = (f32x4){0.f, 0.f, 0.f, 0.f};
    float mcar = 0.f;
    v4u idw[2];
#pragma unroll
    for (int kb = 0; kb < 2; ++kb) { const int tgt = 16 * kb + (tid0 & 15) - 8 * ((tid0 & 63) >> 4);
        idw[kb].x = (tgt == 0 ? 0x3f80u : 0u) | (tgt == 1 ? 0x3f800000u : 0u); idw[kb].y = (tgt == 2 ? 0x3f80u : 0u) | (tgt == 3 ? 0x3f800000u : 0u);
        idw[kb].z = (tgt == 4 ? 0x3f80u : 0u) | (tgt == 5 ? 0x3f800000u : 0u); idw[kb].w = (tgt == 6 ? 0x3f80u : 0u) | (tgt == 7 ? 0x3f800000u : 0u); }
    asm volatile("s_waitcnt vmcnt(0)" ::: "memory"); __syncthreads();
    v4u kr[8], vr[2]; bf16x8 Qf[8]; f32x2 gv[3];
#define P7_PREFETCH(CHN) do { const int m0n = b * SEQ + (CHN) * CH; const int tidp = pg8::fresh_tid(), lp = tidp & 63; \
        _Pragma("unroll") for (int it = 0; it < 8; ++it) { const int p = tidp + 512 * it, row = p >> 5, c16 = p & 31; kr[it] = *(const v4u*)(proj + (size_t)(m0n + row) * NP + 2048 + h * DK + 8 * c16); } \
        _Pragma("unroll") for (int it = 0; it < 2; ++it) { const int p = tidp + 512 * it, sidx = p & 127, cg = p >> 7; vr[it] = *(const v4u*)(proj + (size_t)(m0n + sidx) * NP + 4096 + h * DV + sl * 64 + 8 * cg); } \
        { const bf16* qp = proj + (size_t)(m0n + 16 * tb + (lp & 15)) * NP + h * DK + 8 * (lp >> 4); _Pragma("unroll") for (int ks = 0; ks < 8; ++ks) Qf[ks] = *(const bf16x8*)(qp + 32 * ks); } \
        { const f32x2* g2 = (const f32x2*)(gsc + (CHN) * 384) + lp; gv[0] = g2[0]; gv[1] = g2[64]; gv[2] = g2[128]; } } while (0)
    P7_PREFETCH(0);
    for (int ch = 0; ch < NCH; ++ch) {
        const int m0 = b * SEQ + ch * CH;
        const int tid = pg8::fresh_tid(), lane = tid & 63, l15 = lane & 15, q = lane >> 4;
        const int fsw = ((l15 & 3) << 2) | ((l15 >> 2) & 3);
        {
            const int t0 = 2 * lane;
            const float M0 = fmaxf(mcar, gv[2].x), M1 = fmaxf(mcar, gv[2].y);
            const float Ml = __shfl(M1, 63), gl = __shfl(gv[0].y, 63);
            if (w == 0) {
                *(LAS f32x2*)(ve + t0) = gv[1]; *(LAS f32x2*)(vM + t0) = (f32x2){M0, M1};
                *(LAS f32x2*)(viw + t0) = (f32x2){__expf(mcar - M0), __expf(mcar - M1)};
                *(LAS f32x2*)(vfl + t0) = (f32x2){__expf(-gv[0].x - M0), __expf(-gv[0].y - M1)};
                *(LAS f32x2*)(vw + t0) = (f32x2){__expf(gv[1].x - Ml), __expf(gv[1].y - Ml)};
                if (lane == 0) vsc[0] = __expf(mcar - Ml); }
            mcar = gl + Ml; }
#pragma unroll
        for (int it = 0; it < 8; ++it) { const int row0 = tid >> 5, c16 = tid & 31; *(LAS v4u*)(Kl + p7_koff(row0, c16) + 4096 * it) = kr[it]; }
#pragma unroll
        for (int it = 0; it < 2; ++it) { const int p = tid + 512 * it, sidx = p & 127, cg = p >> 7; const v4u v = vr[it];
            LAS bf16* d = (LAS bf16*)(VT + (8 * cg) * P7_VS) + sidx;
            d[0 * (P7_VS / 2)] = (bf16)(v.x & 0xffffu); d[1 * (P7_VS / 2)] = (bf16)(v.x >> 16); d[2 * (P7_VS / 2)] = (bf16)(v.y & 0xffffu); d[3 * (P7_VS / 2)] = (bf16)(v.y >> 16);
            d[4 * (P7_VS / 2)] = (bf16)(v.z & 0xffffu); d[5 * (P7_VS / 2)] = (bf16)(v.z >> 16); d[6 * (P7_VS / 2)] = (bf16)(v.w & 0xffffu); d[7 * (P7_VS / 2)] = (bf16)(v.w >> 16); }
        LDS_WAIT(); __syncthreads();
        f32x4 accS[8];
#pragma unroll
        for (int js = 0; js < 8; ++js) { accS[js] = (f32x4){0.f, 0.f, 0.f, 0.f};
            if (js <= tb) {
#pragma unroll
            for (int ks = 0; ks < 8; ++ks) { const bf16x8 kf = *(const LAS bf16x8*)(Kl + (256 * l15 + 16 * ((4 * (ks & 3) + q) ^ fsw)) + ((ks >> 2) << 15) + 4096 * js);
                accS[js] = __builtin_amdgcn_mfma_f32_16x16x32_bf16(kf, Qf[ks], accS[js], 0, 0, 0); } } }
        const int tl = 16 * tb + l15; const float Mt = vM[tl], iwt = viw[tl], flt = vfl[tl];
        unsigned pk[8][2];
#pragma unroll
        for (int js = 0; js < 8; ++js) { const f32x4 ev = *(const LAS f32x4*)(ve + 16 * js + 4 * q); const int s0 = 16 * js + 4 * q;
            const float p0 = (s0 + 0 <= tl) ? accS[js][0] * __expf(ev.x - Mt) : 0.f, p1 = (s0 + 1 <= tl) ? accS[js][1] * __expf(ev.y - Mt) : 0.f;
            const float p2 = (s0 + 2 <= tl) ? accS[js][2] * __expf(ev.z - Mt) : 0.f, p3 = (s0 + 3 <= tl) ? accS[js][3] * __expf(ev.w - Mt) : 0.f;
            pk[js][0] = pk2n(p0, p1); pk[js][1] = pk2n(p2, p3); }
        f32x4 acc3[5], acc4[5];
#pragma unroll
        for (int d = 0; d < 5; ++d) { acc3[d] = (f32x4){0.f, 0.f, 0.f, 0.f}; acc4[d] = (f32x4){0.f, 0.f, 0.f, 0.f}; }
#pragma unroll
        for (int a = 0; a < 4; ++a) if (2 * a <= tb) {
            const v4u pu = {pk[2 * a][0], pk[2 * a][1], pk[2 * a + 1][0], pk[2 * a + 1][1]}; const bf16x8 pf = __builtin_bit_cast(bf16x8, pu);
#pragma unroll
            for (int d = 0; d < 5; ++d) { const LAS unsigned char* vp = VT + (16 * d + l15) * P7_VS + 64 * a + 8 * q;
                const v2u lo = *(const LAS v2u*)vp, hi = *(const LAS v2u*)(vp + 32); const v4u vu = {lo.x, lo.y, hi.x, hi.y};
                acc3[d] = __builtin_amdgcn_mfma_f32_16x16x32_bf16(__builtin_bit_cast(bf16x8, vu), pf, acc3[d], 0, 0, 0); } }
#pragma unroll
        for (int ks = 0; ks < 8; ++ks)
#pragma unroll
            for (int d = 0; d < 5; ++d) { const bf16x8 cf = *(const LAS bf16x8*)(CT + (16 * d + l15) * P7_KS + 64 * ks + 16 * q);
                acc4[d] = __builtin_amdgcn_mfma_f32_16x16x32_bf16(cf, Qf[ks], acc4[d], 0, 0, 0); }
        { const float den = __shfl(iwt * acc4[4][0] + acc3[4][0], l15);
          const float inv = 1.0f / fmaxf(fabsf(den), flt); float ss = 0.f;
          bf16* op = hs + (size_t)(m0 + tl) * D + h * DV + sl * 64 + 4 * q;
#pragma unroll
          for (int d = 0; d < 4; ++d) { const float o0 = (iwt * acc4[d][0] + acc3[d][0]) * inv, o1 = (iwt * acc4[d][1] + acc3[d][1]) * inv, o2 = (iwt * acc4[d][2] + acc3[d][2]) * inv, o3 = (iwt * acc4[d][3] + acc3[d][3]) * inv;
              ss += (o0 * o0 + o1 * o1) + (o2 * o2 + o3 * o3); v2u o; o.x = pk2n(o0, o1); o.y = pk2n(o2, o3); *(v2u*)(op + 16 * d) = o; }
          ss += __shfl_xor(ss, 16); ss += __shfl_xor(ss, 32);
          if (q == 0) hsstat[(size_t)(m0 + tl) * 64 + h * 8 + sl] = ss; }
        if (ch + 1 < NCH) P7_PREFETCH(ch + 1);
        { const float dec = vsc[0];
#pragma unroll
          for (int a = 0; a < 2; ++a)
#pragma unroll
              for (int d = 0; d < 5; ++d) accC[a][d] = accC[a][d] * dec; }
#pragma unroll
        for (int a = 0; a < 4; ++a) {
            const f32x4 w0 = *(const LAS f32x4*)(vw + 32 * a + 4 * q), w1 = *(const LAS f32x4*)(vw + 32 * a + 16 + 4 * q);
            bf16x8 kt[2];
            { const int krb = 256 * l15 + 16 * ((4 * (w & 3) + q) ^ fsw) + ((w >> 2) << 15);
              const bf16x8 kr0 = *(const LAS bf16x8*)(Kl + krb + 8192 * a), kr1 = *(const LAS bf16x8*)(Kl + krb + 8192 * a + 4096);
#pragma unroll
              for (int kb = 0; kb < 2; ++kb) { const bf16x8 idf = __builtin_bit_cast(bf16x8, idw[kb]);
                  const f32x4 z4 = {0.f, 0.f, 0.f, 0.f};
                  const f32x4 d0 = __builtin_amdgcn_mfma_f32_16x16x32_bf16(kr0, idf, z4, 0, 0, 0), d1 = __builtin_amdgcn_mfma_f32_16x16x32_bf16(kr1, idf, z4, 0, 0, 0);
                  const v4u ku = {pk2n(d0[0] * w0.x, d0[1] * w0.y), pk2n(d0[2] * w0.z, d0[3] * w0.w), pk2n(d1[0] * w1.x, d1[1] * w1.y), pk2n(d1[2] * w1.z, d1[3] * w1.w)}; kt[kb] = __builtin_bit_cast(bf16x8, ku); } }
#pragma unroll
            for (int d = 0; d < 5; ++d) { const LAS unsigned char* vp = VT + (16 * d + l15) * P7_VS + 64 * a + 8 * q;
                const v2u lo = *(const LAS v2u*)vp, hi = *(const LAS v2u*)(vp + 32); const v4u vu = {lo.x, lo.y, hi.x, hi.y};
                const bf16x8 vf = __builtin_bit_cast(bf16x8, vu);
                accC[0][d] = __builtin_amdgcn_mfma_f32_16x16x32_bf16(kt[0], vf, accC[0][d], 0, 0, 0);
                accC[1][d] = __builtin_amdgcn_mfma_f32_16x16x32_bf16(kt[1], vf, accC[1][d], 0, 0, 0); } }
        LDS_WAIT(); __syncthreads();
#pragma unroll
        for (int kb = 0; kb < 2; ++kb)
#pragma unroll
            for (int d = 0; d < 5; ++d) { v2u o; o.x = pk2n(accC[kb][d][0], accC[kb][d][1]); o.y = pk2n(accC[kb][d][2], accC[kb][d][3]);
                *(LAS v2u*)(CT + (16 * d + l15) * P7_KS + 2 * (16 * (2 * w + kb) + 4 * q)) = o; }
    }
#undef P7_PREFETCH
    LDS_WAIT(); __syncthreads();
}

__device__ __forceinline__ void p8_headnorm(const bf16* hs, bf16* hso, const bf16* __restrict__ proj, const float* __restrict__ hsstat, const float* __restrict__ headg, int c, int wave, int lane) {
    const int pm = ((c & 7) << 3) | ((c >> 3) & 7), sub = c >> 6;
    for (int i = 0; i < 8; ++i) {
        const int m = pm * 256 + sub * 64 + wave * 8 + i;
#pragma unroll
        for (int hd = 0; hd < 8; ++hd) {
            const f32x4 s0 = *(const f32x4*)(hsstat + (size_t)m * 64 + hd * 8), s1 = *(const f32x4*)(hsstat + (size_t)m * 64 + hd * 8 + 4);
            const float rstd = 1.0f / sqrtf((((s0.x + s0.y) + (s0.z + s0.w)) + ((s1.x + s1.y) + (s1.z + s1.w))) * (1.f / DV) + EPS);
            const int col = hd * DV + 8 * lane;
            const v4u hv = *(const v4u*)(hs + (size_t)m * D + col), ov = *(const v4u*)(proj + (size_t)m * NP + 8192 + col);
            const f32x4 g0 = *(const f32x4*)(headg + col), g1 = *(const f32x4*)(headg + col + 4);
            const float hh[8] = {bf_lo(hv.x), bf_hi(hv.x), bf_lo(hv.y), bf_hi(hv.y), bf_lo(hv.z), bf_hi(hv.z), bf_lo(hv.w), bf_hi(hv.w)};
            const float oo[8] = {bf_lo(ov.x), bf_hi(ov.x), bf_lo(ov.y), bf_hi(ov.y), bf_lo(ov.z), bf_hi(ov.z), bf_lo(ov.w), bf_hi(ov.w)};
            const float gg[8] = {g0.x, g0.y, g0.z, g0.w, g1.x, g1.y, g1.z, g1.w};
            float r[8];
#pragma unroll
            for (int e = 0; e < 8; ++e) r[e] = hh[e] * rstd * gg[e] / (1.0f + __expf(-oo[e]));
            v4u o; o.x = pk2(r[0], r[1]); o.y = pk2(r[2], r[3]); o.z = pk2(r[4], r[5]); o.w = pk2(r[6], r[7]);
            *(v4u*)(hso + (size_t)m * D + col) = o;
        }
    }
}

__device__ __forceinline__ void p12_final(const bf16* __restrict__ hb, float* __restrict__ out, const float* __restrict__ hstat, const float* __restrict__ g, int c, int wave, int lane) {
    const int pm = ((c & 7) << 3) | ((c >> 3) & 7), sub = c >> 6;
    for (int i = 0; i < 8; ++i) {
        const int m = pm * 256 + sub * 64 + wave * 8 + i;
        const float sv = hstat[(size_t)m * 64 + lane];
        const float rstd = 1.0f / sqrtf(wave_sum(sv) * (1.f / D) + EPS);
        const v4u* rin = (const v4u*)(hb + (size_t)m * D) + lane; f32x4* row = (f32x4*)(out + (size_t)m * D) + 2 * lane; const f32x4* gr = (const f32x4*)g + 2 * lane;
#pragma unroll
        for (int j = 0; j < 8; ++j) { const v4u w = rin[64 * j]; const f32x4 g0 = gr[128 * j], g1 = gr[128 * j + 1];
            f32x4 v0 = {bf_lo(w.x) * rstd * g0.x, bf_hi(w.x) * rstd * g0.y, bf_lo(w.y) * rstd * g0.z, bf_hi(w.y) * rstd * g0.w};
            f32x4 v1 = {bf_lo(w.z) * rstd * g1.x, bf_hi(w.z) * rstd * g1.y, bf_lo(w.w) * rstd * g1.z, bf_hi(w.w) * rstd * g1.w};
            row[128 * j] = v0; row[128 * j + 1] = v1; }
    }
}

struct Args { const float* in[16]; float* out; unsigned char* ws; int ph_lo, ph_hi, li, pad; };
__global__ void __launch_bounds__(NWAVES * 64, 2) mk_fwd(Args args) {
    extern __shared__ __attribute__((aligned(16))) unsigned char lds_raw[];
    LAS unsigned char* lds = (LAS unsigned char*)lds_raw;
    volatile LAS unsigned* MISC = (volatile LAS unsigned*)(lds + MISC_OFF);
        const int G = gridDim.x, c = blockIdx.x;
    unsigned char* ws = args.ws;
    unsigned* ctl = (unsigned*)(ws + WS_CTL);
    const float* x = args.in[0]; const float* norm_mix = args.in[1]; const float* norm_ffn = args.in[2];
    const float* gm_w_in = args.in[3]; const float* gm_ln_g = args.in[4]; const float* gm_ln_b = args.in[5]; const float* gm_w_s = args.in[6]; const float* gm_b_s = args.in[7];
    const float* gm_w_out = args.in[8]; const float* ml_w_in = args.in[9]; const float* ml_b_gate = args.in[10]; const float* ml_head_g = args.in[11]; const float* ml_w_out = args.in[12];
    const float* ffn_w_up = args.in[13]; const float* ffn_w_down = args.in[14]; const float* norm_final = args.in[15];
    float* out = args.out;
    f32x2* vstat = (f32x2*)(ws + WS_VSTAT); float* hstat = (float*)(ws + WS_HSTAT); float* hsstat = (float*)(ws + WS_HSSTAT); float* gates = (float*)(ws + WS_GATES);
    bf16* W1 = (bf16*)(ws + WS_W1); bf16* W2 = (bf16*)(ws + WS_W2); bf16* WUP0 = (bf16*)(ws + WS_WUP0); bf16* WDN0 = (bf16*)(ws + WS_WDN0);
    bf16* WML = (bf16*)(ws + WS_WML); bf16* WMO = (bf16*)(ws + WS_WMO); bf16* WUP1 = (bf16*)(ws + WS_WUP1); bf16* WDN1 = (bf16*)(ws + WS_WDN1);
    bf16* HB = (bf16*)(ws + WS_HB); bf16* XB = (bf16*)(ws + WS_XB); bf16* Z = (bf16*)(ws + WS_Z); bf16* GATED = (bf16*)(ws + WS_GATED);
    bf16* A = (bf16*)(ws + WS_A); bf16* PROJ = (bf16*)(ws + WS_PROJ); bf16* HS = (bf16*)(ws + WS_HS);
    LAS float* rs = (LAS float*)(lds + RS_OFF);

    if (threadIdx.x < 64) MISC[threadIdx.x] = 0u;
    __syncthreads();
    XcdBarrier bar = xcd_barrier_post(ctl + CW_BAR + args.li * XCD_BAR_WORDS, MISC + 8);

    const int lo = args.ph_lo, hi = args.ph_hi;
#define IN(k) (lo <= (k) && (k) < hi)
#define TID() const int tid = pg8::fresh_tid(), lane = tid & 63, wave = __builtin_amdgcn_readfirstlane(tid >> 6); (void)lane; (void)wave;
#define SEAM(k) do { if (IN(k) && IN((k) + 1)) xcd_barrier(bar); } while (0)

    if (IN(0)) { TID();
        LAS float* scr = (LAS float*)(lds + wave * 16384);
        const int vcu = (c & 7) * (G >> 3) + (c >> 3);
        const int gw = vcu * NWAVES + wave, NGW = G * NWAVES;
        constexpr int I0 = (D / 64) * (NZ / 64), I1 = (D / 64) * (D / 64), I2 = (D / 64) * (FF / 64), I3 = (FF / 64) * (D / 64), I4 = (D / 64) * ((ML_IN + 63) / 64);
        constexpr int NITEMS = I0 + I1 + I2 + I3 + I4 + I1 + I2 + I3;
        for (int it = gw; it < NITEMS; it += NGW) {
            int r = it; WConv wc; int qcols = 0;
            if (r < I0) { wc = WConv{gm_w_in, nullptr, W1, D, NZ}; }
            else if ((r -= I0) < I1) { wc = WConv{gm_w_out, nullptr, W2, D, D}; }
            else if ((r -= I1) < I2) { wc = WConv{ffn_w_up, norm_ffn, WUP0, D, FF}; }
            else if ((r -= I2) < I3) { wc = WConv{ffn_w_down, nullptr, WDN0, FF, D}; }
            else if ((r -= I3) < I4) { wc = WConv{ml_w_in, norm_mix + D, WML, D, ML_IN}; qcols = 2048; }
            else if ((r -= I4) < I1) { wc = WConv{ml_w_out, nullptr, WMO, D, D}; }
            else if ((r -= I1) < I2) { wc = WConv{ffn_w_up + (size_t)D * FF, norm_ffn + D, WUP1, D, FF}; }
            else { r -= I2; wc = WConv{ffn_w_down + (size_t)FF * D, nullptr, WDN1, FF, D}; }
            p0_convert(wc, r, scr, lane, qcols);
        }
        for (int m = gw; m < M; m += NGW) p0_xrow(x + (size_t)m * D, norm_mix, XB + (size_t)m * D, lane);
    }
    SEAM(0);
    if (IN(1)) {
        pg8::Gemm g{XB, W1, M, NZ, D}; pg8::PanelOrder S; S.init(NZ, c);
        pg8::EpiGelu E{Z, NZ, (pg8::f32x2*)vstat};
        pg8::gemm_phase<pg8::EpiGelu, pg8::PanelOrder, true, true>(lds, g, S, E);
    }
    SEAM(1);
    if (IN(2)) { TID(); p2_spatial(lds, Z, vstat, gm_ln_g, gm_ln_b, gm_w_s, gm_b_s, GATED, c, tid); }
    SEAM(2);
    if (IN(3)) {
        pg8::Gemm g{GATED, W2, M, D, D}; pg8::PanelOrder S; S.init(D, c);
        pg8::EpiResid<true> E{x, HB, hstat};
        pg8::gemm_phase<pg8::EpiResid<true>, pg8::PanelOrder, true, true>(lds, g, S, E);
    }
    SEAM(3);
    if (IN(4)) { TID();
        pg8::PanelOrder S; S.init(FF, c);
        load_rstd_table(rs, hstat, S.pm, tid);
        pg8::Gemm g{HB, WUP0, M, FF, D};
        pg8::EpiScale<true> E{A, FF, rs};
        pg8::gemm_phase<pg8::EpiScale<true>, pg8::PanelOrder, true, true>(lds, g, S, E);
    }
    SEAM(4);
    if (IN(5)) {
        pg8::Gemm g{A, WDN0, M, D, FF}; pg8::PanelOrder S; S.init(D, c);
        pg8::EpiResid<false> E{nullptr, HB, hstat};
        pg8::gemm_phase<pg8::EpiResid<false>, pg8::PanelOrder, true, true>(lds, g, S, E);
    }
    SEAM(5);
    if (IN(6)) { TID();
        pg8::PanelOrder S; S.init(NP, c);
        load_rstd_table(rs, hstat, S.pm, tid);
        pg8::Gemm g{HB, WML, M, NP, D};
        pg8::EpiScale<false> E{PROJ, NP, rs};
        pg8::gemm_phase<pg8::EpiScale<false>, pg8::PanelOrder, true, true>(lds, g, S, E);
        p6_gates(HB, WML + (size_t)NP * D, rs, gates, c, wave, lane);
    }
    SEAM(6);
    if (IN(7)) { TID(); p7_mlstm(lds, PROJ, gates, ml_b_gate, HS, hsstat, (float*)(ws + WS_WUP0) + (size_t)c * (NCH * 384), c, tid); }
    SEAM(7);
    if (IN(8)) { TID(); p8_headnorm(HS, HS, PROJ, hsstat, ml_head_g, c, wave, lane); }
    SEAM(8);
    if (IN(9)) {
        pg8::Gemm g{HS, WMO, M, D, D}; pg8::PanelOrder S; S.init(D, c);
        pg8::EpiResid<false> E{nullptr, HB, hstat};
        pg8::gemm_phase<pg8::EpiResid<false>, pg8::PanelOrder, true, true>(lds, g, S, E);
    }
    SEAM(9);
    if (IN(10)) { TID();
        pg8::PanelOrder S; S.init(FF, c);
        load_rstd_table(rs, hstat, S.pm, tid);
        pg8::Gemm g{HB, WUP1, M, FF, D};
        pg8::EpiScale<true> E{A, FF, rs};
        pg8::gemm_phase<pg8::EpiScale<true>, pg8::PanelOrder, true, true>(lds, g, S, E);
    }
    SEAM(10);
    if (IN(11)) {
        pg8::Gemm g{A, WDN1, M, D, FF}; pg8::PanelOrder S; S.init(D, c);
        pg8::EpiResid<false> E{nullptr, HB, hstat};
        pg8::gemm_phase<pg8::EpiResid<false>, pg8::PanelOrder, true, true>(lds, g, S, E);
    }
    SEAM(11);
    if (IN(12)) { TID(); p12_final(HB, out, hstat, norm_final, c, wave, lane); }
#undef IN
#undef SEAM
}

extern "C" void kernel_launch(void* const* d_in, const int* in_sizes, int n_in, void* d_out, int out_size, void* d_ws, size_t ws_size, hipStream_t stream) {
    static int grid = 0;
    if (grid == 0) {
        if (n_in != 16 || in_sizes[0] != M * D || out_size != M * D || ws_size < WS_END) {
            fprintf(stderr, "kernel_launch: unexpected shapes: n_in %d in0 %d out %d ws %zu (need %zu)\n", n_in, n_in > 0 ? in_sizes[0] : -1, out_size, ws_size, (size_t)WS_END); grid = -1; return; }
        if (hipFuncSetAttribute((const void*)mk_fwd, hipFuncAttributeMaxDynamicSharedMemorySize, LDS_BYTES) != hipSuccess) { fprintf(stderr, "kernel_launch: hipFuncSetAttribute failed\n"); grid = -1; return; }
        int per_cu = 0;
        if (hipOccupancyMaxActiveBlocksPerMultiprocessor(&per_cu, (const void*)mk_fwd, NWAVES * 64, LDS_BYTES) != hipSuccess || per_cu < 1)
            fprintf(stderr, "kernel_launch: occupancy query reports %d workgroups per CU\n", per_cu);
        (void)hipGetLastError();
        grid = 256;
    }
    if (grid < 0) return;
    if (hipMemsetAsync((char*)d_ws + WS_CTL, 0, CTL_ZERO_BYTES, stream) != hipSuccess) { fprintf(stderr, "kernel_launch: memset failed\n"); return; }
    Args a{};
    for (int i = 0; i < 16; ++i) a.in[i] = (const float*)d_in[i];
    a.out = (float*)d_out; a.ws = (unsigned char*)d_ws;
#if MK_N_LAUNCHES == 1
    a.ph_lo = 0; a.ph_hi = N_PHASES; a.li = 0;
    hipLaunchKernelGGL(mk_fwd, dim3(grid), dim3(NWAVES * 64), LDS_BYTES, stream, a);
#else
    for (int p = 0; p < N_PHASES; ++p) { a.ph_lo = p; a.ph_hi = p + 1; a.li = 0; hipLaunchKernelGGL(mk_fwd, dim3(grid), dim3(NWAVES * 64), LDS_BYTES, stream, a); }
#endif
    const hipError_t le = hipPeekAtLastError();
    if (le != hipSuccess) fprintf(stderr, "kernel_launch: launch failed: %s\n", hipGetErrorName(le));
}
```

```cpp
#include <hip/hip_runtime.h>
#include <cstdio>
#include <cstdint>
namespace pg8 {
#define PG8_LAS __attribute__((address_space(3)))
typedef unsigned short bf16_t;
typedef short bf16x8 __attribute__((ext_vector_type(8)));
typedef float f32x4 __attribute__((ext_vector_type(4)));
typedef unsigned u32x4 __attribute__((ext_vector_type(4)));
constexpr int BM = 256, BK = 64, HALF = 128, HTB = HALF * BK * 2  , STAGE_BYTES = 8 * HTB, NXCD = 8, WGM = 8;

__host__ __device__ __forceinline__ int lds_byte(int r, int c) { const int st = (r >> 4) * 2 + (c >> 5), rr = r & 15, cc = c & 31, ob = rr * 64 + cc * 2; return st * 1024 + (ob ^ (((ob >> 9) & 1) << 5)); }
__host__ __device__ __forceinline__ void stage_rc(int b, int& R, int& C) { const int st = b / 1024, sb = b % 1024, swz = sb ^ (((sb >> 9) & 1) << 5); R = (st >> 1) * 16 + swz / 64; C = (st & 1) * 32 + (swz % 64) / 2; }
__host__ __device__ __forceinline__ int perm32(int rho) { const int n = rho >> 4, i = rho & 15; return 8 * (i >> 2) + 4 * n + (i & 3); }

struct Unit { int pm, pn; };
struct Gemm { const bf16_t* A; const bf16_t* Bt; int M, N, K; };

struct StaticOrder {
    int nM, nN, nwg, G, c;
    __host__ __device__ void init(int M, int N, int G_, int c_) { nM = M / BM; nN = N / BM; nwg = nM * nN; G = G_; c = c_; }
    __host__ __device__ bool next(int i, Unit& u) const {
        const long L = (long)i * G + c; if (L >= nwg) return false;
        int wgid = (int)L; { const int q = nwg / NXCD, r = nwg % NXCD, xcd = wgid % NXCD, off = wgid / NXCD; wgid = (xcd < r ? xcd * (q + 1) : r * (q + 1) + (xcd - r) * q) + off; }
        const int nig = WGM * nN, gid = wgid / nig, fm = gid * WGM, gsz = (nM - fm) < WGM ? (nM - fm) : WGM;
        u.pm = fm + ((wgid % nig) % gsz); u.pn = (wgid % nig) / gsz; return true;
    }
    __device__ __forceinline__ void a_ready(const Unit&) const {}
    __device__ __forceinline__ void done(const Unit&) const {}
};

struct PanelOrder {
    int pm, pn0, nr;
    __device__ __forceinline__ void init(int N, int c) { pm = ((c & 7) << 3) | ((c >> 3) & 7); pn0 = c >> 6; nr = (N / BM) / 4; }
    __device__ __forceinline__ bool next(int i, Unit& u) const { if (i >= nr) return false; u.pm = pm; u.pn = pn0 + 4 * i; return true; }
    __device__ __forceinline__ void a_ready(const Unit&) const {}
    __device__ __forceinline__ void done(const Unit&) const {}
};

typedef __bf16 bf16x2_native __attribute__((ext_vector_type(2)));
typedef float f32x2_native __attribute__((ext_vector_type(2)));
__device__ __forceinline__ unsigned cvt_pk_bf16_native(float lo, float hi) { const f32x2_native v = {lo, hi}; return __builtin_bit_cast(unsigned, __builtin_convertvector(v, bf16x2_native)); }
__device__ __forceinline__ unsigned cvt_pk_bf16(float lo, float hi) { unsigned r; asm volatile("v_cvt_pk_bf16_f32 %0, %1, %2" : "=v"(r) : "v"(lo), "v"(hi)); return r; }
__device__ __forceinline__ int fresh_tid() { int t = threadIdx.x; asm volatile("" : "+v"(t)); return t; }
#define PG8_FRESH_LANE() const int tz_ = fresh_tid(); const int wid_ = tz_ >> 6, lane_ = tz_ & 63; wr = wid_ >> 2; wc = wid_ & 3; fr = lane_ & 15; fq = lane_ >> 4;
typedef float f32x2 __attribute__((ext_vector_type(2)));
__device__ __forceinline__ f32x2 gelu_pk(f32x2 v) {
    const f32x2 av = __builtin_elementwise_abs(v), d = av * 0.2316418882f + 1.0f;
    f32x2 t; t.x = __builtin_amdgcn_rcpf(d.x); t.y = __builtin_amdgcn_rcpf(d.y);
    f32x2 q = t * 0.5307027145f + (-0.7265760135f); q = q * t + 0.7107068705f; q = q * t + (-0.142248368f); q = q * t + 0.127414796f; q = q * t;
    const f32x2 s = (v * v) * (-0.72134752044f);
    f32x2 e; e.x = __builtin_amdgcn_exp2f(s.x); e.y = __builtin_amdgcn_exp2f(s.y);
    const f32x2 m = v * (q * e), r = v - m;
    f32x2 o; o.x = v.x < 0.f ? m.x : r.x; o.y = v.y < 0.f ? m.y : r.y; return o;
}
__device__ __forceinline__ u32x4 pack8(const f32x4 v0, const f32x4 v1) { u32x4 w; w.x = cvt_pk_bf16(v0[0], v0[1]); w.y = cvt_pk_bf16(v0[2], v0[3]); w.z = cvt_pk_bf16(v1[0], v1[1]); w.w = cvt_pk_bf16(v1[2], v1[3]); return w; }

struct EpiGelu {
    static constexpr bool PERM = true, AFTER_DRAIN = false;
    bf16_t* O; int ldc; f32x2* vstat;
    __device__ __forceinline__ void operator()(const f32x4 (&acc)[2][2][4][2], const Unit& u, int wr, int wc, int fr, int fq) const {
        PG8_FRESH_LANE();
        const int row0 = u.pm * BM + wr * 64 + fr, col0 = u.pn * BM + wc * 32 + 8 * fq;
        const bool st = u.pn >= 16;
#pragma unroll
        for (int ai = 0; ai < 2; ++ai)
#pragma unroll
            for (int m = 0; m < 4; ++m) { const int r = row0 + ai * HALF + m * 16; bf16_t* rowp = O + (size_t)r * ldc + col0; float s1 = 0.f, s2 = 0.f;
#pragma unroll
                for (int bj = 0; bj < 2; ++bj) { f32x4 v0 = acc[ai][bj][m][0], v1 = acc[ai][bj][m][1];
                    const f32x2 a = gelu_pk((f32x2){v0[0], v0[1]}), b = gelu_pk((f32x2){v0[2], v0[3]}), c = gelu_pk((f32x2){v1[0], v1[1]}), d = gelu_pk((f32x2){v1[2], v1[3]});
                    v0 = (f32x4){a.x, a.y, b.x, b.y}; v1 = (f32x4){c.x, c.y, d.x, d.y};
                    s1 += ((v0[0] + v0[1]) + (v0[2] + v0[3])) + ((v1[0] + v1[1]) + (v1[2] + v1[3]));
                    s2 += ((v0[0] * v0[0] + v0[1] * v0[1]) + (v0[2] * v0[2] + v0[3] * v0[3])) + ((v1[0] * v1[0] + v1[1] * v1[1]) + (v1[2] * v1[2] + v1[3] * v1[3]));
                    *(u32x4*)(rowp + bj * HALF) = pack8(v0, v1); }
                s1 += __shfl_xor(s1, 16); s1 += __shfl_xor(s1, 32); s2 += __shfl_xor(s2, 16); s2 += __shfl_xor(s2, 32);
                if (st && fq == 0) vstat[((size_t)r * 16 + (u.pn - 16)) * 4 + wc] = (f32x2){s1, s2}; }
    }
};
template <bool XF32> struct EpiResid {
    static constexpr bool PERM = true, AFTER_DRAIN = false;
    const float* xres; bf16_t* hb; float* hstat;
    __device__ __forceinline__ void operator()(const f32x4 (&acc)[2][2][4][2], const Unit& u, int wr, int wc, int fr, int fq) const {
        PG8_FRESH_LANE();
        const int row0 = u.pm * BM + wr * 64 + fr, col0 = u.pn * BM + wc * 32 + 8 * fq;
#pragma unroll
        for (int g = 0; g < 8; ++g) { const int ai = g >> 2, m = g & 3;
            const int r = row0 + ai * HALF + m * 16; const size_t off = (size_t)r * 4096 + col0; float s2 = 0.f;
            f32x4 r0[2], r1[2];
#pragma unroll
            for (int bj = 0; bj < 2; ++bj) {
                if (XF32) { r0[bj] = *(const f32x4*)(xres + off + bj * HALF); r1[bj] = *(const f32x4*)(xres + off + bj * HALF + 4); }
                else { const u32x4 w = *(const u32x4*)(hb + off + bj * HALF);
                    r0[bj] = (f32x4){__builtin_bit_cast(float, w.x << 16), __builtin_bit_cast(float, w.x & 0xffff0000u), __builtin_bit_cast(float, w.y << 16), __builtin_bit_cast(float, w.y & 0xffff0000u)};
                    r1[bj] = (f32x4){__builtin_bit_cast(float, w.z << 16), __builtin_bit_cast(float, w.z & 0xffff0000u), __builtin_bit_cast(float, w.w << 16), __builtin_bit_cast(float, w.w & 0xffff0000u)}; } }
#pragma unroll
            for (int bj = 0; bj < 2; ++bj) { const f32x4 v0 = acc[ai][bj][m][0] + r0[bj], v1 = acc[ai][bj][m][1] + r1[bj];
                s2 += ((v0[0] * v0[0] + v0[1] * v0[1]) + (v0[2] * v0[2] + v0[3] * v0[3])) + ((v1[0] * v1[0] + v1[1] * v1[1]) + (v1[2] * v1[2] + v1[3] * v1[3]));
                *(u32x4*)(hb + off + bj * HALF) = pack8(v0, v1); }
            s2 += __shfl_xor(s2, 16); s2 += __shfl_xor(s2, 32);
            if (fq == 0) hstat[((size_t)r * 16 + u.pn) * 4 + wc] = s2;
            asm volatile("" ::: "memory"); }
    }
};
template <bool SQ> struct EpiScale {
    static constexpr bool PERM = true, AFTER_DRAIN = false;
    bf16_t* O; int ldc; const PG8_LAS float* rs;
    __device__ __forceinline__ void operator()(const f32x4 (&acc)[2][2][4][2], const Unit& u, int wr, int wc, int fr, int fq) const {
        PG8_FRESH_LANE();
        const int rl0 = wr * 64 + fr, col0 = u.pn * BM + wc * 32 + 8 * fq;
#pragma unroll
        for (int ai = 0; ai < 2; ++ai)
#pragma unroll
            for (int m = 0; m < 4; ++m) { const int rl = rl0 + ai * HALF + m * 16; const float sc = rs[rl]; bf16_t* rowp = O + (size_t)(u.pm * BM + rl) * ldc + col0;
#pragma unroll
                for (int bj = 0; bj < 2; ++bj) { f32x4 v0 = acc[ai][bj][m][0] * sc, v1 = acc[ai][bj][m][1] * sc;
                    if (SQ) {
#pragma unroll
                        for (int j = 0; j < 4; ++j) { const float a = fmaxf(v0[j], 0.f), b = fmaxf(v1[j], 0.f); v0[j] = a * a; v1[j] = b * b; } }
                    *(u32x4*)(rowp + bj * HALF) = pack8(v0, v1); } }
    }
};
template <class Epi, class Sched, bool ALIGN_EPI = false, bool SP2 = false>
__device__ __forceinline__ void gemm_phase(PG8_LAS unsigned char* lds, const Gemm g, const Sched& S, const Epi& E) {
    const int tid = threadIdx.x, wid = __builtin_amdgcn_readfirstlane(tid >> 6), lane = tid & 63, wr = wid >> 2, wc = wid & 3, fr = lane & 15, fq = lane >> 4;
    const int K = g.K, nt = K / BK;
    unsigned voffA[2], voffB[2];
#pragma unroll
    for (int i = 0; i < 2; ++i) { int R, C; stage_rc(tid * 16 + i * 8192, R, C); const int Rb = Epi::PERM ? ((R & ~31) + perm32(R & 31)) : R;
        voffA[i] = (unsigned)(R * K + C) * 2u; voffB[i] = (unsigned)(Rb * K + C) * 2u; }
    const size_t kstep = (size_t)(BK * 2);
    const size_t hstep = (size_t)HALF * K * 2;
    const size_t tstep = 2 * hstep;
    const unsigned ldsw = (unsigned)wid * 1024u;
    const int aoff = lds_byte(wr * 64 + fr, fq * 8), boff = lds_byte(wc * 32 + fr, fq * 8);
#define PG8_SA(b, h) (((b) * 2 + (h)) * HTB)
#define PG8_SB(b, h) ((4 + (b) * 2 + (h)) * HTB)
#define PG8_STAGE(bufoff, gbase, voff) do { _Pragma("unroll") for (int _i = 0; _i < 2; ++_i) \
        __builtin_amdgcn_global_load_lds((const unsigned*)((const char*)(gbase) + (voff)[_i]), (PG8_LAS unsigned*)(lds + (bufoff) + ldsw + _i * 8192), 16, 0, 0); } while (0)
#define PG8_LDA(dst, b, h) do { _Pragma("unroll") for (int m = 0; m < 4; ++m) _Pragma("unroll") for (int k = 0; k < 2; ++k) dst[m][k] = *(const PG8_LAS bf16x8*)(lds + PG8_SA(b, h) + aoff + m * 2048 + k * 1024); } while (0)
#define PG8_LDB(dst, b, h) do { _Pragma("unroll") for (int n = 0; n < 2; ++n) _Pragma("unroll") for (int k = 0; k < 2; ++k) dst[n][k] = *(const PG8_LAS bf16x8*)(lds + PG8_SB(b, h) + boff + n * 2048 + k * 1024); } while (0)
#define PG8_MMA(ai, bj, At, Bt) do { __builtin_amdgcn_s_setprio(1); _Pragma("unroll") for (int m = 0; m < 4; ++m) _Pragma("unroll") for (int n = 0; n < 2; ++n) _Pragma("unroll") for (int k = 0; k < 2; ++k) \
        acc[ai][bj][m][n] = __builtin_amdgcn_mfma_f32_16x16x32_bf16(Bt[n][k], At[m][k], acc[ai][bj][m][n], 0, 0, 0); __builtin_amdgcn_s_setprio(0); } while (0)
#define PG8_WAIT_V(n) asm volatile("s_waitcnt vmcnt(" #n ")" ::: "memory")
#define PG8_WAIT_L(n) asm volatile("s_waitcnt lgkmcnt(" #n ")" ::: "memory")
#define PG8_BAR __builtin_amdgcn_s_barrier()
#define PG8_SCHED __builtin_amdgcn_sched_barrier(0)
    Unit cur, nxt; int ui = 0;
    if (!S.next(0, cur)) return;
    f32x4 acc[2][2][4][2];
#pragma unroll
    for (int a = 0; a < 2; ++a)
#pragma unroll
        for (int b = 0; b < 2; ++b)
#pragma unroll
            for (int m = 0; m < 4; ++m)
#pragma unroll
                for (int n = 0; n < 2; ++n) acc[a][b][m][n] = (f32x4){0.f, 0.f, 0.f, 0.f};
    bf16x8 At[4][2], B0[2][2], B1[2][2];
    const char* cA = (const char*)g.A + (size_t)cur.pm * tstep; const char* cB = (const char*)g.Bt + (size_t)cur.pn * tstep;
    S.a_ready(cur);
    if constexpr (SP2) {
        PG8_STAGE(PG8_SB(0, 0), cB, voffB); PG8_STAGE(PG8_SB(0, 1), cB + hstep, voffB); PG8_STAGE(PG8_SA(0, 0), cA, voffA); PG8_STAGE(PG8_SA(0, 1), cA + hstep, voffA);
        if (wr == 1) PG8_BAR;
        PG8_WAIT_V(2); PG8_BAR;
        PG8_STAGE(PG8_SB(1, 0), cB + kstep, voffB); PG8_STAGE(PG8_SA(1, 0), cA + kstep, voffA); PG8_STAGE(PG8_SB(1, 1), cB + hstep + kstep, voffB);
        PG8_WAIT_V(6); PG8_BAR;
    } else {
        PG8_STAGE(PG8_SB(0, 0), cB, voffB); PG8_STAGE(PG8_SA(0, 0), cA, voffA); PG8_STAGE(PG8_SB(0, 1), cB + hstep, voffB); PG8_STAGE(PG8_SA(0, 1), cA + hstep, voffA);
        if (wr == 1) PG8_BAR;
        PG8_WAIT_V(4); PG8_BAR;
        PG8_STAGE(PG8_SB(1, 0), cB + kstep, voffB); PG8_STAGE(PG8_SA(1, 0), cA + kstep, voffA); PG8_STAGE(PG8_SB(1, 1), cB + hstep + kstep, voffB);
        PG8_WAIT_V(6); PG8_BAR;
    }
    for (;;) {
        const bool has_next = S.next(ui + 1, nxt);
        const char* nA = has_next ? (const char*)g.A + (size_t)nxt.pm * tstep : cA; const char* nB = has_next ? (const char*)g.Bt + (size_t)nxt.pn * tstep : cB;
        for (int t = 0; t < nt; t += 2) {
            const bool last = (t == nt - 2);
            const char* a1 = cA + (size_t)(t + 1) * kstep;
            const char* a2 = last ? nA : cA + (size_t)(t + 2) * kstep; const char* b2 = last ? nB : cB + (size_t)(t + 2) * kstep;
            const char* a3 = a2 + kstep; const char* b3 = b2 + kstep;
            if (last && has_next) S.a_ready(nxt);
            if constexpr (SP2) {
            PG8_LDB(B0, 0, 0); PG8_LDB(B1, 0, 1); PG8_SCHED; PG8_LDA(At, 0, 0); PG8_STAGE(PG8_SA(1, 1), a1 + hstep, voffA);
            PG8_WAIT_V(8); PG8_WAIT_L(0); PG8_BAR; PG8_MMA(0, 0, At, B0); PG8_MMA(0, 1, At, B1); PG8_BAR; PG8_SCHED;
            PG8_LDA(At, 0, 1); PG8_STAGE(PG8_SB(0, 0), b2, voffB); PG8_STAGE(PG8_SB(0, 1), b2 + hstep, voffB); PG8_STAGE(PG8_SA(0, 0), a2, voffA);
            PG8_WAIT_V(8); PG8_WAIT_L(0); PG8_BAR; PG8_MMA(1, 0, At, B0); PG8_MMA(1, 1, At, B1); PG8_BAR; PG8_SCHED;
            PG8_LDB(B0, 1, 0); PG8_LDB(B1, 1, 1); PG8_SCHED; PG8_LDA(At, 1, 0); PG8_STAGE(PG8_SA(0, 1), a2 + hstep, voffA);
            PG8_WAIT_V(8); PG8_WAIT_L(0); PG8_BAR; PG8_MMA(0, 0, At, B0); PG8_MMA(0, 1, At, B1); PG8_BAR; PG8_SCHED;
            PG8_LDA(At, 1, 1); PG8_STAGE(PG8_SB(1, 0), b3, voffB); PG8_STAGE(PG8_SB(1, 1), b3 + hstep, voffB); PG8_STAGE(PG8_SA(1, 0), a3, voffA);
            PG8_WAIT_V(8); PG8_WAIT_L(0); PG8_BAR; PG8_MMA(1, 0, At, B0); PG8_MMA(1, 1, At, B1); PG8_BAR; PG8_SCHED;
            } else {
            PG8_LDB(B0, 0, 0); PG8_SCHED; PG8_LDA(At, 0, 0); PG8_STAGE(PG8_SA(1, 1), a1 + hstep, voffA);
            PG8_WAIT_L(8); PG8_BAR; PG8_WAIT_L(0); PG8_MMA(0, 0, At, B0); PG8_BAR; PG8_SCHED;
            PG8_LDB(B1, 0, 1); PG8_STAGE(PG8_SB(0, 0), b2, voffB);
            PG8_BAR; PG8_WAIT_L(0); PG8_MMA(0, 1, At, B1); PG8_BAR;
            PG8_LDA(At, 0, 1); PG8_STAGE(PG8_SA(0, 0), a2, voffA);
            PG8_BAR; PG8_WAIT_L(0); PG8_MMA(1, 0, At, B0); PG8_BAR; PG8_SCHED;
            PG8_STAGE(PG8_SB(0, 1), b2 + hstep, voffB);
            PG8_WAIT_V(6); PG8_BAR; PG8_MMA(1, 1, At, B1); PG8_BAR;
            PG8_LDB(B0, 1, 0); PG8_SCHED; PG8_LDA(At, 1, 0); PG8_STAGE(PG8_SA(0, 1), a2 + hstep, voffA);
            PG8_WAIT_L(8); PG8_BAR; PG8_WAIT_L(0); PG8_MMA(0, 0, At, B0); PG8_BAR; PG8_SCHED;
            PG8_LDB(B1, 1, 1); PG8_STAGE(PG8_SB(1, 0), b3, voffB);
            PG8_BAR; PG8_WAIT_L(0); PG8_MMA(0, 1, At, B1); PG8_BAR;
            PG8_LDA(At, 1, 1); PG8_STAGE(PG8_SA(1, 0), a3, voffA);
            PG8_BAR; PG8_WAIT_L(0); PG8_MMA(1, 0, At, B0); PG8_BAR; PG8_SCHED;
            PG8_STAGE(PG8_SB(1, 1), b3 + hstep, voffB);
            PG8_WAIT_V(6); PG8_BAR; PG8_MMA(1, 1, At, B1); PG8_BAR;
            }
        }
        if constexpr (ALIGN_EPI) { if (wr == 0) PG8_BAR; }
        if constexpr (!Epi::AFTER_DRAIN) { E(acc, cur, wr, wc, fr, fq); S.done(cur); }
        if (!has_next) break;
#pragma unroll
        for (int a = 0; a < 2; ++a)
#pragma unroll
            for (int b = 0; b < 2; ++b)
#pragma unroll
                for (int m = 0; m < 4; ++m)
#pragma unroll
                    for (int n = 0; n < 2; ++n) acc[a][b][m][n] = (f32x4){0.f, 0.f, 0.f, 0.f};
        cur = nxt; cA = nA; cB = nB; ++ui;
        if constexpr (ALIGN_EPI) { if (wr == 1) PG8_BAR; }
    }
    PG8_WAIT_V(0);
    if constexpr (!ALIGN_EPI) { if (wr == 0) PG8_BAR; }
    PG8_BAR;
    if constexpr (Epi::AFTER_DRAIN) { E.fused(acc, cur, wr, wc, fr, fq, lds, wid, lane); S.done(cur); }
#undef PG8_SA
#undef PG8_SB
#undef PG8_STAGE
#undef PG8_LDA
#undef PG8_LDB
#undef PG8_MMA
#undef PG8_WAIT_V
#undef PG8_WAIT_L
#undef PG8_BAR
#undef PG8_SCHED
}
}

constexpr int NWAVES = 8;
constexpr int BATCH = 4, SEQ = 4096, D = 4096, M = BATCH * SEQ, FF = 4 * D;
constexpr int NZ = 2 * D;
constexpr int HEADS = 8, DK = 256, DV = 512, CH = 128, NCH = SEQ / CH;
constexpr int NP = 2 * HEADS * DK + 2 * HEADS * DV;
constexpr int ML_IN = NP + 2 * HEADS;
constexpr float EPS = 1e-6f;
constexpr float GATE_CAP = 15.0f;
#ifndef MK_N_LAUNCHES
#define MK_N_LAUNCHES 1
#endif
constexpr int N_PHASES = 13;

constexpr size_t MiB = 1u << 20;
constexpr size_t WS_CTL = 0, CTL_ZERO_BYTES = 1 * MiB;
constexpr size_t WS_VSTAT = 1 * MiB;
constexpr size_t WS_HSTAT = 9 * MiB;
constexpr size_t WS_HSSTAT = 13 * MiB;
constexpr size_t WS_GATES = 17 * MiB;
constexpr size_t WS_W1 = 32 * MiB;
constexpr size_t WS_W2 = 96 * MiB;
constexpr size_t WS_WUP0 = 128 * MiB;
constexpr size_t WS_WDN0 = 256 * MiB;
constexpr size_t WS_WML = 384 * MiB;
constexpr size_t WS_WMO = 481 * MiB;
constexpr size_t WS_WUP1 = 513 * MiB;
constexpr size_t WS_WDN1 = 641 * MiB;
constexpr size_t WS_HB = 769 * MiB;
constexpr size_t WS_R = 897 * MiB;
constexpr size_t WS_XB = WS_R, WS_Z = WS_R + 128 * MiB, WS_GATED = WS_R + 384 * MiB;
constexpr size_t WS_A = WS_R;
constexpr size_t WS_PROJ = WS_R, WS_HS = WS_R + 384 * MiB;
constexpr size_t WS_END = WS_R + 512 * MiB;
static_assert(WS_WML + (size_t)ML_IN * D * 2 <= WS_WMO, "ws map");
constexpr int CW_BAR = 4096;

constexpr int RING_BYTES = 131072;
constexpr int RS_OFF = RING_BYTES;
constexpr int LDS_BYTES = 147456;
constexpr int MISC_OFF = LDS_BYTES - 256;

#define LAS __attribute__((address_space(3)))
typedef unsigned short bf16;
typedef unsigned v4u __attribute__((ext_vector_type(4)));
typedef unsigned v2u __attribute__((ext_vector_type(2)));
typedef float f32x4 __attribute__((ext_vector_type(4)));
typedef float f32x2 __attribute__((ext_vector_type(2)));
typedef short bf16x8 __attribute__((ext_vector_type(8)));
typedef short s16x4 __attribute__((ext_vector_type(4)));
#define LDS_WAIT() asm volatile("s_waitcnt lgkmcnt(0)" ::: "memory")
__device__ __forceinline__ unsigned f2bf(float f) { unsigned u = __builtin_bit_cast(unsigned, f); return (u + 0x7fffu + ((u >> 16) & 1u)) >> 16; }
__device__ __forceinline__ unsigned pk2(float lo, float hi) { return pg8::cvt_pk_bf16(lo, hi); }
__device__ __forceinline__ unsigned pk2n(float lo, float hi) { return pg8::cvt_pk_bf16_native(lo, hi); }
__device__ __forceinline__ float bf_lo(unsigned u) { return __builtin_bit_cast(float, u << 16); }
__device__ __forceinline__ float bf_hi(unsigned u) { return __builtin_bit_cast(float, u & 0xffff0000u); }
__device__ __forceinline__ float wave_sum(float v) {
#pragma unroll
    for (int o = 1; o < 64; o <<= 1) v += __shfl_xor(v, o);
    return v;
}
#define XB_TMO      128
#define XB_XCNT(j)  (256  + 64 * (j))
#define XB_XSUB(j)  (1280 + 64 * (j))
#define XB_XGEN(j)  (2304 + 64 * (j))
#define XB_TOP      3328
#define XB_TOPGEN   3392
#define XCD_BAR_WORDS 3456
#define XB_SPIN_CAP (1u << 18)

__device__ __forceinline__ unsigned xb_ld(unsigned* p)              { return __hip_atomic_load(p, __ATOMIC_RELAXED, __HIP_MEMORY_SCOPE_AGENT); }
__device__ __forceinline__ unsigned xb_add(unsigned* p, unsigned v) { return __hip_atomic_fetch_add(p, v, __ATOMIC_RELAXED, __HIP_MEMORY_SCOPE_AGENT); }
__device__ __forceinline__ unsigned xb_xcc_id() { return (unsigned)__builtin_amdgcn_s_getreg((3 << 11) | 20) & 0xFu; }
#define XB_SPIN(cond, bar) do { unsigned _sp = 0; while (cond) { __builtin_amdgcn_s_sleep(1); \
    if ((++_sp & 255u) == 0u) { if (xb_ld(&(bar)[XB_TMO])) break; if (_sp > XB_SPIN_CAP) { atomicAdd(&(bar)[XB_TMO], 1u); break; } } } } while (0)

struct XcdBarrier {
    unsigned* bar; unsigned x;
    volatile LAS unsigned* st;
};

__device__ __forceinline__ XcdBarrier xcd_barrier_post(unsigned* bar, volatile LAS unsigned* st) {
    XcdBarrier b; b.bar = bar; b.x = xb_xcc_id(); b.st = st;
    if (threadIdx.x == 0) (void)xb_add(&bar[XB_XCNT(b.x)], 1u);
    return b;
}
__device__ __forceinline__ void xcd_barrier_complete(unsigned* bar, unsigned x, unsigned& nloc, unsigned& nx) {
    const unsigned G = gridDim.x * gridDim.y * gridDim.z;
    unsigned sum, cnt, mine, sp = 0u;
    for (;;) {
        sum = 0u; cnt = 0u; mine = 0u;
#pragma unroll
        for (unsigned j = 0; j < 16; ++j) { const unsigned c = xb_ld(&bar[XB_XCNT(j)]); sum += c; cnt += (c > 0u) ? 1u : 0u; mine = (j == x) ? c : mine; }
        if (sum == G) break;
        __builtin_amdgcn_s_sleep(1);
        if ((++sp & 255u) == 0u) { if (xb_ld(&bar[XB_TMO])) break; if (sp > XB_SPIN_CAP) { atomicAdd(&bar[XB_TMO], 1u); break; } }
    }
    nloc = mine > 0u ? mine : 1u; nx = cnt > 0u ? cnt : 1u;
}

__device__ __forceinline__ void xcd_barrier(const XcdBarrier& b) {
    asm volatile("s_waitcnt vmcnt(0)" ::: "memory");
    __syncthreads();
    if (threadIdx.x == 0) {
        unsigned* bar = b.bar;
        __builtin_amdgcn_s_waitcnt(0);
        unsigned nloc = b.st[0], nx = b.st[1];
        if (nloc == 0u) { xcd_barrier_complete(bar, b.x, nloc, nx); b.st[0] = nloc; b.st[1] = nx; }
        const unsigned old = xb_add(&bar[XB_XSUB(b.x)], 1u);
        const unsigned gen = old / nloc;
        if (old + 1u == (gen + 1u) * nloc) {
            __builtin_amdgcn_fence(__ATOMIC_RELEASE, "agent");
            asm volatile("s_waitcnt vmcnt(0)" ::: "memory");
            const unsigned og = xb_add(&bar[XB_TOP], 1u);
            const unsigned tg = og / nx;
            if (og + 1u == (tg + 1u) * nx) xb_add(&bar[XB_TOPGEN], 1u);
            else XB_SPIN(xb_ld(&bar[XB_TOPGEN]) == tg, bar);
            __builtin_amdgcn_fence(__ATOMIC_ACQUIRE, "agent");
            xb_add(&bar[XB_XGEN(b.x)], 1u);
            asm volatile("s_waitcnt vmcnt(0)" ::: "memory");
        } else {
            XB_SPIN(xb_ld(&bar[XB_XGEN(b.x)]) == gen, bar);
            __builtin_amdgcn_fence(__ATOMIC_ACQUIRE, "agent");
            asm volatile("s_waitcnt vmcnt(0)" ::: "memory");
        }
    }
    __syncthreads();
}

__device__ __forceinline__ void p0_transpose_item(const float* __restrict__ W, int Nsrc, int K, int k0, int n0, int ncols, const float* __restrict__ gk, float cs,
                                                  bf16* __restrict__ WT, LAS float* scr, int lane) {
    const int nq = lane & 15, kh = lane >> 4;
    const bool okc = 4 * nq < ncols;
    f32x4 v[16];
    const float* src = W + (size_t)(k0 + kh) * Nsrc + n0 + 4 * nq;
#pragma unroll
    for (int i = 0; i < 16; ++i) v[i] = okc ? __builtin_nontemporal_load((const f32x4*)(src + (size_t)(4 * i) * Nsrc)) : (f32x4){0.f, 0.f, 0.f, 0.f};
    const int c = lane & 7;
    f32x4 g0 = {cs, cs, cs, cs}, g1 = {cs, cs, cs, cs};
    if (gk) { g0 = *(const f32x4*)(gk + k0 + 8 * c) * cs; g1 = *(const f32x4*)(gk + k0 + 8 * c + 4) * cs; }
#pragma unroll
    for (int i = 0; i < 16; ++i) { const int kk = 4 * i + kh; *(LAS f32x4*)(scr + kk * 64 + ((4 * nq) ^ (4 * ((kk >> 3) & 7)))) = v[i]; }
    LDS_WAIT(); asm volatile("" ::: "memory");
#pragma unroll
    for (int j = 0; j < 8; ++j) { const int n = (lane >> 3) + 8 * j; const LAS float* sp = scr + (8 * c) * 64 + (n ^ (4 * c));
        v4u o; o.x = pk2(sp[0 * 64] * g0.x, sp[1 * 64] * g0.y); o.y = pk2(sp[2 * 64] * g0.z, sp[3 * 64] * g0.w); o.z = pk2(sp[4 * 64] * g1.x, sp[5 * 64] * g1.y); o.w = pk2(sp[6 * 64] * g1.z, sp[7 * 64] * g1.w);
        if (n < ncols) *(v4u*)(WT + (size_t)(n0 + n) * K + k0 + 8 * c) = o; }
    LDS_WAIT(); asm volatile("" ::: "memory");
}
struct WConv { const float* W; const float* gk; bf16* WT; int K, Nsrc; };
__device__ __forceinline__ void p0_convert(const WConv& w, int item, LAS float* scr, int lane, int qcols) {
    const int nnb = (w.Nsrc + 63) / 64, kb = item / nnb, nb = item - kb * nnb, n0 = nb * 64;
    const int ncols = (w.Nsrc - n0) < 64 ? (w.Nsrc - n0) : 64;
    p0_transpose_item(w.W, w.Nsrc, w.K, kb * 64, n0, ncols, w.gk, n0 < qcols ? 0.0625f : 1.0f, w.WT, scr, lane);
}
__device__ __forceinline__ void p0_xrow(const float* __restrict__ xrow, const float* __restrict__ g, bf16* __restrict__ orow, int lane) {
    const f32x4* xr = (const f32x4*)xrow + lane; const f32x4* gr = (const f32x4*)g + lane;
    f32x4 v[16]; float s = 0.f;
#pragma unroll
    for (int j = 0; j < 16; ++j) { v[j] = __builtin_nontemporal_load(xr + 64 * j); s += (v[j].x * v[j].x + v[j].y * v[j].y) + (v[j].z * v[j].z + v[j].w * v[j].w); }
    const float rstd = 1.0f / sqrtf(wave_sum(s) * (1.f / D) + EPS);
    v2u* o8 = (v2u*)orow + lane;
#pragma unroll
    for (int j = 0; j < 16; ++j) { const f32x4 gg = gr[64 * j]; v2u o; o.x = pk2(v[j].x * rstd * gg.x, v[j].y * rstd * gg.y); o.y = pk2(v[j].z * rstd * gg.z, v[j].w * rstd * gg.w); o8[64 * j] = o; }
}

__device__ __forceinline__ void load_rstd_table(LAS float* rs, const float* __restrict__ hstat, int pm, int tid) {
    const int row = tid >> 1, half = tid & 1;
    const f32x4* p = (const f32x4*)(hstat + ((size_t)(pm * 256 + row) * 64 + half * 32));
    float s = 0.f;
#pragma unroll
    for (int j = 0; j < 8; ++j) { const f32x4 v = p[j]; s += (v.x + v.y) + (v.z + v.w); }
    s += __shfl_xor(s, 1);
    if (half == 0) rs[row] = 1.0f / sqrtf(s * (1.f / D) + EPS);
    LDS_WAIT(); __syncthreads();
}

__device__ __forceinline__ int img_off(int row, int ch) { return 256 * row + 16 * (ch ^ (((row & 3) << 2) | ((row >> 2) & 3))); }
__device__ __forceinline__ void p2_spatial(LAS unsigned char* lds, const bf16* __restrict__ z, const f32x2* __restrict__ vstat, const float* __restrict__ lng, const float* __restrict__ lnb,
                                           const float* __restrict__ ws_, const float* __restrict__ bs_, bf16* __restrict__ gated, int c, int tid0) {
    LAS unsigned char* Wimg = lds;
    LAS unsigned char* Vimg = lds + 32768;
    LAS float* mu = (LAS float*)(lds + 131072);
    LAS float* rsd = mu + 256;
    const int pm = ((c & 7) << 3) | ((c >> 3) & 7), sub = c >> 6;
    const int w = __builtin_amdgcn_readfirstlane(tid0 >> 6), jq = w & 3, th = w >> 2;
    __syncthreads();
    { const int row = tid0 >> 1, part = tid0 & 1;
      const f32x4* p = (const f32x4*)(vstat + ((size_t)(pm * 256 + row) * 64 + part * 32));
      float s1 = 0.f, s2 = 0.f;
#pragma unroll
      for (int j = 0; j < 16; ++j) { const f32x4 v = p[j]; s1 += v.x + v.z; s2 += v.y + v.w; }
      s1 += __shfl_xor(s1, 1); s2 += __shfl_xor(s2, 1);
      const float mean = s1 * (1.f / D); const float var = fmaxf(s2 * (1.f / D) - mean * mean, 0.f);
      if (part == 0) { mu[row] = mean; rsd[row] = 1.0f / sqrtf(var + EPS); } }
    v4u raw[8];
#define P2_LOADV(STEP) do { const int hi_ = (STEP) >> 2, cc_ = ((STEP) >> 1) & 1, hf_ = (STEP) & 1; const int tp = pg8::fresh_tid(); \
        const bf16* vp_ = z + (size_t)(pm * 256 + cc_ * 128 + (tp >> 5)) * NZ + D + (2 * sub + hi_) * 512 + hf_ * 256 + 8 * (tp & 31); \
        _Pragma("unroll") for (int it = 0; it < 8; ++it) raw[it] = *(const v4u*)(vp_ + (size_t)(16 * it) * NZ); } while (0)
    P2_LOADV(0);
    for (int step = 0; step < 8; ++step) {
        const int hi = step >> 2, cc = (step >> 1) & 1, hf = step & 1, hh = 2 * sub + hi;
        const int m0 = pm * 256 + cc * 128, j0 = hh * 512 + hf * 256;
        __syncthreads();
        if ((step & 3) == 0) { const int tid = pg8::fresh_tid();
#pragma unroll
          for (int it = 0; it < 4; ++it) { const int p = tid + 512 * it, t = p >> 4, ch = p & 15, s0 = 8 * ch;
              const f32x4 a = *(const f32x4*)(ws_ + ((size_t)hh * 128 + t) * 128 + s0), b = *(const f32x4*)(ws_ + ((size_t)hh * 128 + t) * 128 + s0 + 4);
              v4u o; o.x = pk2(s0 + 0 <= t ? a.x : 0.f, s0 + 1 <= t ? a.y : 0.f); o.y = pk2(s0 + 2 <= t ? a.z : 0.f, s0 + 3 <= t ? a.w : 0.f);
              o.z = pk2(s0 + 4 <= t ? b.x : 0.f, s0 + 5 <= t ? b.y : 0.f); o.w = pk2(s0 + 6 <= t ? b.z : 0.f, s0 + 7 <= t ? b.w : 0.f);
              *(LAS v4u*)(Wimg + img_off(t, ch)) = o; } }
        { const int tid = pg8::fresh_tid();
          const int cg = tid & 31; float g8[8], b8[8];
          { const f32x4 a = *(const f32x4*)(lng + j0 + 8 * cg), b = *(const f32x4*)(lng + j0 + 8 * cg + 4); g8[0] = a.x; g8[1] = a.y; g8[2] = a.z; g8[3] = a.w; g8[4] = b.x; g8[5] = b.y; g8[6] = b.z; g8[7] = b.w; }
          { const f32x4 a = *(const f32x4*)(lnb + j0 + 8 * cg), b = *(const f32x4*)(lnb + j0 + 8 * cg + 4); b8[0] = a.x; b8[1] = a.y; b8[2] = a.z; b8[3] = a.w; b8[4] = b.x; b8[5] = b.y; b8[6] = b.z; b8[7] = b.w; }
#pragma unroll
          for (int it = 0; it < 8; ++it) { const int sr = (tid >> 5) + 16 * it; const float mm = mu[cc * 128 + sr], rr = rsd[cc * 128 + sr];
              float f[8] = {bf_lo(raw[it].x), bf_hi(raw[it].x), bf_lo(raw[it].y), bf_hi(raw[it].y), bf_lo(raw[it].z), bf_hi(raw[it].z), bf_lo(raw[it].w), bf_hi(raw[it].w)};
#pragma unroll
              for (int e = 0; e < 8; ++e) f[e] = (f[e] - mm) * rr * g8[e] + b8[e];
              v4u o; o.x = pk2(f[0], f[1]); o.y = pk2(f[2], f[3]); o.z = pk2(f[4], f[5]); o.w = pk2(f[6], f[7]);
              *(LAS v4u*)(Vimg + ((cg >> 4) << 15) + img_off(sr, cg & 15)) = o; } }
        LDS_WAIT(); __syncthreads();
        if (step + 1 < 8) P2_LOADV(step + 1);
        const int tid = pg8::fresh_tid(), lane = tid & 63, l15 = lane & 15, q = lane >> 4;
        const int nks = 2 * th + 2;
        v2u uu[4][4]; float bsv[4];
#pragma unroll
        for (int tbq = 0; tbq < 4; ++tbq) { const int t = 16 * (4 * th + tbq) + l15; bsv[tbq] = bs_[hh * 128 + t];
#pragma unroll
            for (int jb = 0; jb < 4; ++jb) uu[jb][tbq] = *(const v2u*)(z + (size_t)(m0 + t) * NZ + j0 + 64 * jq + 16 * jb + 4 * q); }
#pragma unroll
        for (int jb = 0; jb < 4; ++jb) {
            const int jbl = 4 * jq + jb, cI = jbl & 7; const LAS unsigned char* vb = Vimg + ((jbl >> 3) << 15);
            bf16x8 Af[4];
#pragma unroll
            for (int ks = 0; ks < 4; ++ks) { if (ks < nks) {
                const int r0 = 32 * ks + 8 * q + (l15 >> 2), c8 = 2 * cI + ((l15 & 3) >> 1);
                const s16x4 t0 = __builtin_amdgcn_ds_read_tr16_b64_v4i16((LAS s16x4*)(vb + img_off(r0, c8) + 8 * (l15 & 1)));
                const s16x4 t1 = __builtin_amdgcn_ds_read_tr16_b64_v4i16((LAS s16x4*)(vb + img_off(r0 + 4, c8) + 8 * (l15 & 1)));
                Af[ks] = (bf16x8){t0[0], t0[1], t0[2], t0[3], t1[0], t1[1], t1[2], t1[3]}; } else Af[ks] = (bf16x8){0, 0, 0, 0, 0, 0, 0, 0}; }
#pragma unroll
            for (int tbq = 0; tbq < 4; ++tbq) {
                const int tb = 4 * th + tbq; f32x4 acc = {0.f, 0.f, 0.f, 0.f};
#pragma unroll
                for (int ks = 0; ks < 4; ++ks) if (2 * ks <= tb) { const bf16x8 bfr = *(const LAS bf16x8*)(Wimg + img_off(16 * tb + l15, 4 * ks + q));
                    acc = __builtin_amdgcn_mfma_f32_16x16x32_bf16(Af[ks], bfr, acc, 0, 0, 0); }
                const int t = 16 * tb + l15, j = j0 + 64 * jq + 16 * jb + 4 * q; const float bb = bsv[tbq]; const v2u u2 = uu[jb][tbq];
                v2u o; o.x = pk2n(bf_lo(u2.x) * (acc[0] + bb), bf_hi(u2.x) * (acc[1] + bb)); o.y = pk2n(bf_lo(u2.y) * (acc[2] + bb), bf_hi(u2.y) * (acc[3] + bb));
                *(v2u*)(gated + (size_t)(m0 + t) * D + j) = o;
            }
        }
    }
#undef P2_LOADV
}

__device__ __forceinline__ void p6_gates(const bf16* __restrict__ hb, const bf16* __restrict__ wg, const LAS float* rs, float* __restrict__ gates, int c, int wave, int lane) {
    if (wave >= 4) return;
    const int pm = ((c & 7) << 3) | ((c >> 3) & 7), sub = c >> 6;
    const int rl0 = 64 * sub + 16 * wave, l15 = lane & 15, q = lane >> 4;
    const bf16* ap = hb + (size_t)(pm * 256 + rl0 + l15) * D + 8 * q;
    const bf16* bp = wg + (size_t)l15 * D + 8 * q;
    f32x4 acc0 = {0.f, 0.f, 0.f, 0.f}, acc1 = {0.f, 0.f, 0.f, 0.f};
#pragma unroll 4
    for (int ks = 0; ks < D / 32; ks += 2) {
        const bf16x8 a0 = *(const bf16x8*)(ap + 32 * ks), b0 = *(const bf16x8*)(bp + 32 * ks);
        const bf16x8 a1 = *(const bf16x8*)(ap + 32 * ks + 32), b1 = *(const bf16x8*)(bp + 32 * ks + 32);
        acc0 = __builtin_amdgcn_mfma_f32_16x16x32_bf16(a0, b0, acc0, 0, 0, 0);
        acc1 = __builtin_amdgcn_mfma_f32_16x16x32_bf16(a1, b1, acc1, 0, 0, 0);
    }
#pragma unroll
    for (int r = 0; r < 4; ++r) { const int rl = rl0 + 4 * q + r; gates[(size_t)(pm * 256 + rl) * 16 + l15] = (acc0[r] + acc1[r]) * rs[rl]; }
}

constexpr int P7_KS = 528, P7_VS = 272, P7_K_OFF = 0, P7_VT_OFF = 65536, P7_CT_OFF = P7_VT_OFF + 80 * P7_VS, P7_VEC_OFF = P7_CT_OFF + 80 * P7_KS;
__device__ __forceinline__ int p7_koff(int row, int dk8  ) { const int ch = dk8 & 15; return ((dk8 >> 4) << 15) + 256 * row + 16 * (ch ^ (((row & 3) << 2) | ((row >> 2) & 3))); }
static_assert(P7_VEC_OFF + 4096 <= MISC_OFF && P7_VT_OFF % 16 == 0 && P7_CT_OFF % 16 == 0 && P7_VEC_OFF % 16 == 0, "P7 LDS map");
__device__ __forceinline__ void p7_mlstm(LAS unsigned char* lds, const bf16* __restrict__ proj, const float* __restrict__ gates, const float* __restrict__ bgate,
                                         bf16* __restrict__ hs, float* __restrict__ hsstat, float* __restrict__ gsc  , int c, int tid0) {
    const int w = __builtin_amdgcn_readfirstlane(tid0 >> 6);
    const int tb = w < 4 ? w : 11 - w;
    const int xcd = c & 7, y = c >> 3, bh = 8 * (y >> 3) + xcd, sl = y & 7, b = bh >> 3, h = bh & 7;
    LAS unsigned char* Kl = lds + P7_K_OFF; LAS unsigned char* VT = lds + P7_VT_OFF; LAS unsigned char* CT = lds + P7_CT_OFF;
    LAS float* ve = (LAS float*)(lds + P7_VEC_OFF);
    LAS float* vM = ve + 128, *viw = ve + 256, *vfl = ve + 384, *vw = ve + 512, *vsc = ve + 640;
    __syncthreads();
    for (int i = tid0; i < 80 * P7_KS / 4; i += 512) ((LAS unsigned*)CT)[i] = 0u;
    for (int i = tid0; i < 16 * P7_VS / 4; i += 512) ((LAS unsigned*)(VT + 64 * P7_VS))[i] = (i < P7_VS / 4) ? 0x3f803f80u : 0u;
    { const float bi = bgate[h], bfg = bgate[8 + h]; const int lane = tid0 & 63, t0 = 2 * lane;
      for (int ch = w; ch < NCH; ch += 8) { const int m0 = b * SEQ + ch * CH;
          float ip[2], lf[2];
#pragma unroll
          for (int k = 0; k < 2; ++k) { const float gi = gates[(size_t)(m0 + t0 + k) * 16 + h] + bi, gf = gates[(size_t)(m0 + t0 + k) * 16 + 8 + h] + bfg;
              ip[k] = GATE_CAP * tanhf(gi * (1.f / GATE_CAP)); const float fp = GATE_CAP * tanhf(gf * (1.f / GATE_CAP));
              lf[k] = fminf(fp, 0.f) - log1pf(expf(-fabsf(fp))); }
          const float pair = lf[0] + lf[1]; float inc = pair;
#pragma unroll
          for (int o = 1; o < 64; o <<= 1) { const float n = __shfl_up(inc, o); if (lane >= o) inc += n; }
          const float bc0 = (inc - pair) + lf[0], bc1 = inc;
          const float e0 = ip[0] - bc0, e1 = ip[1] - bc1;
          float im = fmaxf(e0, e1);
#pragma unroll
          for (int o = 1; o < 64; o <<= 1) { const float n = __shfl_up(im, o); if (lane >= o) im = fmaxf(im, n); }
          float ex = __shfl_up(im, 1); if (lane == 0) ex = -3.0e38f;
          f32x2* g2 = (f32x2*)(gsc + ch * 384) + lane;
          g2[0] = (f32x2){bc0, bc1}; g2[64] = (f32x2){e0, e1}; g2[128] = (f32x2){fmaxf(ex, e0), im}; } }
    f32x4 accC[2][5];
#pragma unroll
    for (int a = 0; a < 2; ++a)
#pragma unroll
        for (int d = 0; d < 5; ++d) accC[a][d] = (f32x4){0.f, 0.f, 0.f, 0.f};
    float mcar = 0.f;
    v4u idw[2];
#pragma unroll
    for (int kb = 0; kb < 2; ++kb) { const int tgt = 16 * kb + (tid0 & 15) - 8 * ((tid0 & 63) >> 4);
        idw[kb].x = (tgt == 0 ? 0x3f80u : 0u) | (tgt == 1 ? 0x3f800000u : 0u); idw[kb].y = (tgt == 2 ? 0x3f80u : 0u) | (tgt == 3 ? 0x3f800000u : 0u);
        idw[kb].z = (tgt == 4 ? 0x3f80u : 0u) | (tgt == 5 ? 0x3f800000u : 0u); idw[kb].w = (tgt == 6 ? 0x3f80u : 0u) | (tgt == 7 ? 0x3f800000u : 0u); }
    asm volatile("s_waitcnt vmcnt(0)" ::: "memory"); __syncthreads();
    v4u kr[8], vr[2]; bf16x8 Qf[8]; f32x2 gv[3];
#define P7_PREFETCH(CHN) do { const int m0n = b * SEQ + (CHN) * CH; const int tidp = pg8::fresh_tid(), lp = tidp & 63; \
        _Pragma("unroll") for (int it = 0; it < 8; ++it) { const int p = tidp + 512 * it, row = p >> 5, c16 = p & 31; kr[it] = *(const v4u*)(proj + (size_t)(m0n + row) * NP + 2048 + h * DK + 8 * c16); } \
        _Pragma("unroll") for (int it = 0; it < 2; ++it) { const int p = tidp + 512 * it, sidx = p & 127, cg = p >> 7; vr[it] = *(const v4u*)(proj + (size_t)(m0n + sidx) * NP + 4096 + h * DV + sl * 64 + 8 * cg); } \
        { const bf16* qp = proj + (size_t)(m0n + 16 * tb + (lp & 15)) * NP + h * DK + 8 * (lp >> 4); _Pragma("unroll") for (int ks = 0; ks < 8; ++ks) Qf[ks] = *(const bf16x8*)(qp + 32 * ks); } \
        { const f32x2* g2 = (const f32x2*)(gsc + (CHN) * 384) + lp; gv[0] = g2[0]; gv[1] = g2[64]; gv[2] = g2[128]; } } while (0)
    P7_PREFETCH(0);
    for (int ch = 0; ch < NCH; ++ch) {
        const int m0 = b * SEQ + ch * CH;
        const int tid = pg8::fresh_tid(), lane = tid & 63, l15 = lane & 15, q = lane >> 4;
        const int fsw = ((l15 & 3) << 2) | ((l15 >> 2) & 3);
        {
            const int t0 = 2 * lane;
            const float M0 = fmaxf(mcar, gv[2].x), M1 = fmaxf(mcar, gv[2].y);
            const float Ml = __shfl(M1, 63), gl = __shfl(gv[0].y, 63);
            if (w == 0) {
                *(LAS f32x2*)(ve + t0) = gv[1]; *(LAS f32x2*)(vM + t0) = (f32x2){M0, M1};
                *(LAS f32x2*)(viw + t0) = (f32x2){__expf(mcar - M0), __expf(mcar - M1)};
                *(LAS f32x2*)(vfl + t0) = (f32x2){__expf(-gv[0].x - M0), __expf(-gv[0].y - M1)};
                *(LAS f32x2*)(vw + t0) = (f32x2){__expf(gv[1].x - Ml), __expf(gv[1].y - Ml)};
                if (lane == 0) vsc[0] = __expf(mcar - Ml); }
            mcar = gl + Ml; }
#pragma unroll
        for (int it = 0; it < 8; ++it) { const int row0 = tid >> 5, c16 = tid & 31; *(LAS v4u*)(Kl + p7_koff(row0, c16) + 4096 * it) = kr[it]; }
#pragma unroll
        for (int it = 0; it < 2; ++it) { const int p = tid + 512 * it, sidx = p & 127, cg = p >> 7; const v4u v = vr[it];
            LAS bf16* d = (LAS bf16*)(VT + (8 * cg) * P7_VS) + sidx;
            d[0 * (P7_VS / 2)] = (bf16)(v.x & 0xffffu); d[1 * (P7_VS / 2)] = (bf16)(v.x >> 16); d[2 * (P7_VS / 2)] = (bf16)(v.y & 0xffffu); d[3 * (P7_VS / 2)] = (bf16)(v.y >> 16);
            d[4 * (P7_VS / 2)] = (bf16)(v.z & 0xffffu); d[5 * (P7_VS / 2)] = (bf16)(v.z >> 16); d[6 * (P7_VS / 2)] = (bf16)(v.w & 0xffffu); d[7 * (P7_VS / 2)] = (bf16)(v.w >> 16); }
        LDS_WAIT(); __syncthreads();
        f32x4 accS[8];
#pragma unroll
        for (int js = 0; js < 8; ++js) { accS[js] = (f32x4){0.f, 0.f, 0.f, 0.f};
            if (js <= tb) {
#pragma unroll
            for (int ks = 0; ks < 8; ++ks) { const bf16x8 kf = *(const LAS bf16x8*)(Kl + (256 * l15 + 16 * ((4 * (ks & 3) + q) ^ fsw)) + ((ks >> 2) << 15) + 4096 * js);
                accS[js] = __builtin_amdgcn_mfma_f32_16x16x32_bf16(kf, Qf[ks], accS[js], 0, 0, 0); } } }
        const int tl = 16 * tb + l15; const float Mt = vM[tl], iwt = viw[tl], flt = vfl[tl];
        unsigned pk[8][2];
#pragma unroll
        for (int js = 0; js < 8; ++js) { const f32x4 ev = *(const LAS f32x4*)(ve + 16 * js + 4 * q); const int s0 = 16 * js + 4 * q;
            const float p0 = (s0 + 0 <= tl) ? accS[js][0] * __expf(ev.x - Mt) : 0.f, p1 = (s0 + 1 <= tl) ? accS[js][1] * __expf(ev.y - Mt) : 0.f;
            const float p2 = (s0 + 2 <= tl) ? accS[js][2] * __expf(ev.z - Mt) : 0.f, p3 = (s0 + 3 <= tl) ? accS[js][3] * __expf(ev.w - Mt) : 0.f;
            pk[js][0] = pk2n(p0, p1); pk[js][1] = pk2n(p2, p3); }
        f32x4 acc3[5], acc4[5];
#pragma unroll
        for (int d = 0; d < 5; ++d) { acc3[d] = (f32x4){0.f, 0.f, 0.f, 0.f}; acc4[d] = (f32x4){0.f, 0.f, 0.f, 0.f}; }
#pragma unroll
        for (int a = 0; a < 4; ++a) if (2 * a <= tb) {
            const v4u pu = {pk[2 * a][0], pk[2 * a][1], pk[2 * a + 1][0], pk[2 * a + 1][1]}; const bf16x8 pf = __builtin_bit_cast(bf16x8, pu);
#pragma unroll
            for (int d = 0; d < 5; ++d) { const LAS unsigned char* vp = VT + (16 * d + l15) * P7_VS + 64 * a + 8 * q;
                const v2u lo = *(const LAS v2u*)vp, hi = *(const LAS v2u*)(vp + 32); const v4u vu = {lo.x, lo.y, hi.x, hi.y};
                acc3[d] = __builtin_amdgcn_mfma_f32_16x16x32_bf16(__builtin_bit_cast(bf16x8, vu), pf, acc3[d], 0, 0, 0); } }
#pragma unroll
        for (int ks = 0; ks < 8; ++ks)
#pragma unroll
            for (int d = 0; d < 5; ++d) { const bf16x8 cf = *(const LAS bf16x8*)(CT + (16 * d + l15) * P7_KS + 64 * ks + 16 * q);
                acc4[d] = __builtin_amdgcn_mfma_f32_16x16x32_bf16(cf, Qf[ks], acc4[d], 0, 0, 0); }
        { const float den = __shfl(iwt * acc4[4][0] + acc3[4][0], l15);
          const float inv = 1.0f / fmaxf(fabsf(den), flt); float ss = 0.f;
          bf16* op = hs + (size_t)(m0 + tl) * D + h * DV + sl * 64 + 4 * q;
#pragma unroll
          for (int d = 0; d < 4; ++d) { const float o0 = (iwt * acc4[d][0] + acc3[d][0]) * inv, o1 = (iwt * acc4[d][1] + acc3[d][1]) * inv, o2 = (iwt * acc4[d][2] + acc3[d][2]) * inv, o3 = (iwt * acc4[d][3] + acc3[d][3]) * inv;
              ss += (o0 * o0 + o1 * o1) + (o2 * o2 + o3 * o3); v2u o; o.x = pk2n(o0, o1); o.y = pk2n(o2, o3); *(v2u*)(op + 16 * d) = o; }
          ss += __shfl_xor(ss, 16); ss += __shfl_xor(ss, 32);
          if (q == 0) hsstat[(size_t)(m0 + tl) * 64 + h * 8 + sl] = ss; }
        if (ch + 1 < NCH) P7_PREFETCH(ch + 1);
        { const float dec = vsc[0];
#pragma unroll
          for (int a = 0; a < 2; ++a)
#pragma unroll
              for (int d = 0; d < 5; ++d) accC[a][d] = accC[a][d] * dec; }
#pragma unroll
        for (int a = 0; a < 4; ++a) {
            const f32x4 w0 = *(const LAS f32x4*)(vw + 32 * a + 4 * q), w1 = *(const LAS f32x4*)(vw + 32 * a + 16 + 4 * q);
            bf16x8 kt[2];
            { const int krb = 256 * l15 + 16 * ((4 * (w & 3) + q) ^ fsw) + ((w >> 2) << 15);
              const bf16x8 kr0 = *(const LAS bf16x8*)(Kl + krb + 8192 * a), kr1 = *(const LAS bf16x8*)(Kl + krb + 8192 * a + 4096);
#pragma unroll
              for (int kb = 0; kb < 2; ++kb) { const bf16x8 idf = __builtin_bit_cast(bf16x8, idw[kb]);
                  const f32x4 z4 = {0.f, 0.f, 0.f, 0.f};
                  const f32x4 d0 = __builtin_amdgcn_mfma_f32_16x16x32_bf16(kr0, idf, z4, 0, 0, 0), d1 = __builtin_amdgcn_mfma_f32_16x16x32_bf16(kr1, idf, z4, 0, 0, 0);
                  const v4u ku = {pk2n(d0[0] * w0.x, d0[1] * w0.y), pk2n(d0[2] * w0.z, d0[3] * w0.w), pk2n(d1[0] * w1.x, d1[1] * w1.y), pk2n(d1[2] * w1.z, d1[3] * w1.w)}; kt[kb] = __builtin_bit_cast(bf16x8, ku); } }
#pragma unroll
            for (int d = 0; d < 5; ++d) { const LAS unsigned char* vp = VT + (16 * d + l15) * P7_VS + 64 * a + 8 * q;
                const v2u lo = *(const LAS v2u*)vp, hi = *(const LAS v2u*)(vp + 32); const v4u vu = {lo.x, lo.y, hi.x, hi.y};
                const bf16x8 vf = __builtin_bit_cast(bf16x8, vu);
                accC[0][d] = __builtin_amdgcn_mfma_f32_16x16x32_bf16(kt[0], vf, accC[0][d], 0, 0, 0);
                accC[1][d] = __builtin_amdgcn_mfma_f32_16x16x32_bf16(kt[1], vf, accC[1][d], 0, 0, 0); } }
        LDS_WAIT(); __syncthreads();
#pragma unroll
        for (int kb = 0; kb < 2; ++kb)
#pragma unroll
            for (int d = 0; d < 5; ++d) { v2u o; o.x = pk2n(accC[kb][d][0], accC[kb][d][1]); o.y = pk2n(accC[kb][d][2], accC[kb][d][3]);
                *(LAS v2u*)(CT + (16 * d + l15) * P7_KS + 2 * (16 * (2 * w + kb) + 4 * q)) = o; }
    }
#undef P7_PREFETCH
    LDS_WAIT(); __syncthreads();
}

__device__ __forceinline__ void p8_headnorm(const bf16* hs, bf16* hso, const bf16* __restrict__ proj, const float* __restrict__ hsstat, const float* __restrict__ headg, int c, int wave, int lane) {
    const int pm = ((c & 7) << 3) | ((c >> 3) & 7), sub = c >> 6;
    for (int i = 0; i < 8; ++i) {
        const int m = pm * 256 + sub * 64 + wave * 8 + i;
#pragma unroll
        for (int hd = 0; hd < 8; ++hd) {
            const f32x4 s0 = *(const f32x4*)(hsstat + (size_t)m * 64 + hd * 8), s1 = *(const f32x4*)(hsstat + (size_t)m * 64 + hd * 8 + 4);
            const float rstd = 1.0f / sqrtf((((s0.x + s0.y) + (s0.z + s0.w)) + ((s1.x + s1.y) + (s1.z + s1.w))) * (1.f / DV) + EPS);
            const int col = hd * DV + 8 * lane;
            const v4u hv = *(const v4u*)(hs + (size_t)m * D + col), ov = *(const v4u*)(proj + (size_t)m * NP + 8192 + col);
            const f32x4 g0 = *(const f32x4*)(headg + col), g1 = *(const f32x4*)(headg + col + 4);
            const float hh[8] = {bf_lo(hv.x), bf_hi(hv.x), bf_lo(hv.y), bf_hi(hv.y), bf_lo(hv.z), bf_hi(hv.z), bf_lo(hv.w), bf_hi(hv.w)};
            const float oo[8] = {bf_lo(ov.x), bf_hi(ov.x), bf_lo(ov.y), bf_hi(ov.y), bf_lo(ov.z), bf_hi(ov.z), bf_lo(ov.w), bf_hi(ov.w)};
            const float gg[8] = {g0.x, g0.y, g0.z, g0.w, g1.x, g1.y, g1.z, g1.w};
            float r[8];
#pragma unroll
            for (int e = 0; e < 8; ++e) r[e] = hh[e] * rstd * gg[e] / (1.0f + __expf(-oo[e]));
            v4u o; o.x = pk2(r[0], r[1]); o.y = pk2(r[2], r[3]); o.z = pk2(r[4], r[5]); o.w = pk2(r[6], r[7]);
            *(v4u*)(hso + (size_t)m * D + col) = o;
        }
    }
}

__device__ __forceinline__ void p12_final(const bf16* __restrict__ hb, float* __restrict__ out, const float* __restrict__ hstat, const float* __restrict__ g, int c, int wave, int lane) {
    const int pm = ((c & 7) << 3) | ((c >> 3) & 7), sub = c >> 6;
    for (int i = 0; i < 8; ++i) {
        const int m = pm * 256 + sub * 64 + wave * 8 + i;
        const float sv = hstat[(size_t)m * 64 + lane];
        const float rstd = 1.0f / sqrtf(wave_sum(sv) * (1.f / D) + EPS);
        const v4u* rin = (const v4u*)(hb + (size_t)m * D) + lane; f32x4* row = (f32x4*)(out + (size_t)m * D) + 2 * lane; const f32x4* gr = (const f32x4*)g + 2 * lane;
#pragma unroll
        for (int j = 0; j < 8; ++j) { const v4u w = rin[64 * j]; const f32x4 g0 = gr[128 * j], g1 = gr[128 * j + 1];
            f32x4 v0 = {bf_lo(w.x) * rstd * g0.x, bf_hi(w.x) * rstd * g0.y, bf_lo(w.y) * rstd * g0.z, bf_hi(w.y) * rstd * g0.w};
            f32x4 v1 = {bf_lo(w.z) * rstd * g1.x, bf_hi(w.z) * rstd * g1.y, bf_lo(w.w) * rstd * g1.z, bf_hi(w.w) * rstd * g1.w};
            row[128 * j] = v0; row[128 * j + 1] = v1; }
    }
}

struct Args { const float* in[16]; float* out; unsigned char* ws; int ph_lo, ph_hi, li, pad; };
__global__ void __launch_bounds__(NWAVES * 64, 2) mk_fwd(Args args) {
    extern __shared__ __attribute__((aligned(16))) unsigned char lds_raw[];
    LAS unsigned char* lds = (LAS unsigned char*)lds_raw;
    volatile LAS unsigned* MISC = (volatile LAS unsigned*)(lds + MISC_OFF);
        const int G = gridDim.x, c = blockIdx.x;
    unsigned char* ws = args.ws;
    unsigned* ctl = (unsigned*)(ws + WS_CTL);
    const float* x = args.in[0]; const float* norm_mix = args.in[1]; const float* norm_ffn = args.in[2];
    const float* gm_w_in = args.in[3]; const float* gm_ln_g = args.in[4]; const float* gm_ln_b = args.in[5]; const float* gm_w_s = args.in[6]; const float* gm_b_s = args.in[7];
    const float* gm_w_out = args.in[8]; const float* ml_w_in = args.in[9]; const float* ml_b_gate = args.in[10]; const float* ml_head_g = args.in[11]; const float* ml_w_out = args.in[12];
    const float* ffn_w_up = args.in[13]; const float* ffn_w_down = args.in[14]; const float* norm_final = args.in[15];
    float* out = args.out;
    f32x2* vstat = (f32x2*)(ws + WS_VSTAT); float* hstat = (float*)(ws + WS_HSTAT); float* hsstat = (float*)(ws + WS_HSSTAT); float* gates = (float*)(ws + WS_GATES);
    bf16* W1 = (bf16*)(ws + WS_W1); bf16* W2 = (bf16*)(ws + WS_W2); bf16* WUP0 = (bf16*)(ws + WS_WUP0); bf16* WDN0 = (bf16*)(ws + WS_WDN0);
    bf16* WML = (bf16*)(ws + WS_WML); bf16* WMO = (bf16*)(ws + WS_WMO); bf16* WUP1 = (bf16*)(ws + WS_WUP1); bf16* WDN1 = (bf16*)(ws + WS_WDN1);
    bf16* HB = (bf16*)(ws + WS_HB); bf16* XB = (bf16*)(ws + WS_XB); bf16* Z = (bf16*)(ws + WS_Z); bf16* GATED = (bf16*)(ws + WS_GATED);
    bf16* A = (bf16*)(ws + WS_A); bf16* PROJ = (bf16*)(ws + WS_PROJ); bf16* HS = (bf16*)(ws + WS_HS);
    LAS float* rs = (LAS float*)(lds + RS_OFF);

    if (threadIdx.x < 64) MISC[threadIdx.x] = 0u;
    __syncthreads();
    XcdBarrier bar = xcd_barrier_post(ctl + CW_BAR + args.li * XCD_BAR_WORDS, MISC + 8);

    const int lo = args.ph_lo, hi = args.ph_hi;
#define IN(k) (lo <= (k) && (k) < hi)
#define TID() const int tid = pg8::fresh_tid(), lane = tid & 63, wave = __builtin_amdgcn_readfirstlane(tid >> 6); (void)lane; (void)wave;
#define SEAM(k) do { if (IN(k) && IN((k) + 1)) xcd_barrier(bar); } while (0)

    if (IN(0)) { TID();
        LAS float* scr = (LAS float*)(lds + wave * 16384);
        const int vcu = (c & 7) * (G >> 3) + (c >> 3);
        const int gw = vcu * NWAVES + wave, NGW = G * NWAVES;
        constexpr int I0 = (D / 64) * (NZ / 64), I1 = (D / 64) * (D / 64), I2 = (D / 64) * (FF / 64), I3 = (FF / 64) * (D / 64), I4 = (D / 64) * ((ML_IN + 63) / 64);
        constexpr int NITEMS = I0 + I1 + I2 + I3 + I4 + I1 + I2 + I3;
        for (int it = gw; it < NITEMS; it += NGW) {
            int r = it; WConv wc; int qcols = 0;
            if (r < I0) { wc = WConv{gm_w_in, nullptr, W1, D, NZ}; }
            else if ((r -= I0) < I1) { wc = WConv{gm_w_out, nullptr, W2, D, D}; }
            else if ((r -= I1) < I2) { wc = WConv{ffn_w_up, norm_ffn, WUP0, D, FF}; }
            else if ((r -= I2) < I3) { wc = WConv{ffn_w_down, nullptr, WDN0, FF, D}; }
            else if ((r -= I3) < I4) { wc = WConv{ml_w_in, norm_mix + D, WML, D, ML_IN}; qcols = 2048; }
            else if ((r -= I4) < I1) { wc = WConv{ml_w_out, nullptr, WMO, D, D}; }
            else if ((r -= I1) < I2) { wc = WConv{ffn_w_up + (size_t)D * FF, norm_ffn + D, WUP1, D, FF}; }
            else { r -= I2; wc = WConv{ffn_w_down + (size_t)FF * D, nullptr, WDN1, FF, D}; }
            p0_convert(wc, r, scr, lane, qcols);
        }
        for (int m = gw; m < M; m += NGW) p0_xrow(x + (size_t)m * D, norm_mix, XB + (size_t)m * D, lane);
    }
    SEAM(0);
    if (IN(1)) {
        pg8::Gemm g{XB, W1, M, NZ, D}; pg8::PanelOrder S; S.init(NZ, c);
        pg8::EpiGelu E{Z, NZ, (pg8::f32x2*)vstat};
        pg8::gemm_phase<pg8::EpiGelu, pg8::PanelOrder, true, true>(lds, g, S, E);
    }
    SEAM(1);
    if (IN(2)) { TID(); p2_spatial(lds, Z, vstat, gm_ln_g, gm_ln_b, gm_w_s, gm_b_s, GATED, c, tid); }
    SEAM(2);
    if (IN(3)) {
        pg8::Gemm g{GATED, W2, M, D, D}; pg8::PanelOrder S; S.init(D, c);
        pg8::EpiResid<true> E{x, HB, hstat};
        pg8::gemm_phase<pg8::EpiResid<true>, pg8::PanelOrder, true, true>(lds, g, S, E);
    }
    SEAM(3);
    if (IN(4)) { TID();
        pg8::PanelOrder S; S.init(FF, c);
        load_rstd_table(rs, hstat, S.pm, tid);
        pg8::Gemm g{HB, WUP0, M, FF, D};
        pg8::EpiScale<true> E{A, FF, rs};
        pg8::gemm_phase<pg8::EpiScale<true>, pg8::PanelOrder, true, true>(lds, g, S, E);
    }
    SEAM(4);
    if (IN(5)) {
        pg8::Gemm g{A, WDN0, M, D, FF}; pg8::PanelOrder S; S.init(D, c);
        pg8::EpiResid<false> E{nullptr, HB, hstat};
        pg8::gemm_phase<pg8::EpiResid<false>, pg8::PanelOrder, true, true>(lds, g, S, E);
    }
    SEAM(5);
    if (IN(6)) { TID();
        pg8::PanelOrder S; S.init(NP, c);
        load_rstd_table(rs, hstat, S.pm, tid);
        pg8::Gemm g{HB, WML, M, NP, D};
        pg8::EpiScale<false> E{PROJ, NP, rs};
        pg8::gemm_phase<pg8::EpiScale<false>, pg8::PanelOrder, true, true>(lds, g, S, E);
        p6_gates(HB, WML + (size_t)NP * D, rs, gates, c, wave, lane);
    }
    SEAM(6);
    if (IN(7)) { TID(); p7_mlstm(lds, PROJ, gates, ml_b_gate, HS, hsstat, (float*)(ws + WS_WUP0) + (size_t)c * (NCH * 384), c, tid); }
    SEAM(7);
    if (IN(8)) { TID(); p8_headnorm(HS, HS, PROJ, hsstat, ml_head_g, c, wave, lane); }
    SEAM(8);
    if (IN(9)) {
        pg8::Gemm g{HS, WMO, M, D, D}; pg8::PanelOrder S; S.init(D, c);
        pg8::EpiResid<false> E{nullptr, HB, hstat};
        pg8::gemm_phase<pg8::EpiResid<false>, pg8::PanelOrder, true, true>(lds, g, S, E);
    }
    SEAM(9);
    if (IN(10)) { TID();
        pg8::PanelOrder S; S.init(FF, c);
        load_rstd_table(rs, hstat, S.pm, tid);
        pg8::Gemm g{HB, WUP1, M, FF, D};
        pg8::EpiScale<true> E{A, FF, rs};
        pg8::gemm_phase<pg8::EpiScale<true>, pg8::PanelOrder, true, true>(lds, g, S, E);
    }
    SEAM(10);
    if (IN(11)) {
        pg8::Gemm g{A, WDN1, M, D, FF}; pg8::PanelOrder S; S.init(D, c);
        pg8::EpiResid<false> E{nullptr, HB, hstat};
        pg8::gemm_phase<pg8::EpiResid<false>, pg8::PanelOrder, true, true>(lds, g, S, E);
    }
    SEAM(11);
    if (IN(12)) { TID(); p12_final(HB, out, hstat, norm_final, c, wave, lane); }
#undef IN
#undef SEAM
}

extern "C" void kernel_launch(void* const* d_in, const int* in_sizes, int n_in, void* d_out, int out_size, void* d_ws, size_t ws_size, hipStream_t stream) {
    static int grid = 0;
    if (grid == 0) {
        if (n_in != 16 || in_sizes[0] != M * D || out_size != M * D || ws_size < WS_END) {
            fprintf(stderr, "kernel_launch: unexpected shapes: n_in %d in0 %d out %d ws %zu (need %zu)\n", n_in, n_in > 0 ? in_sizes[0] : -1, out_size, ws_size, (size_t)WS_END); grid = -1; return; }
        if (hipFuncSetAttribute((const void*)mk_fwd, hipFuncAttributeMaxDynamicSharedMemorySize, LDS_BYTES) != hipSuccess) { fprintf(stderr, "kernel_launch: hipFuncSetAttribute failed\n"); grid = -1; return; }
        int per_cu = 0;
        if (hipOccupancyMaxActiveBlocksPerMultiprocessor(&per_cu, (const void*)mk_fwd, NWAVES * 64, LDS_BYTES) != hipSuccess || per_cu < 1)
            fprintf(stderr, "kernel_launch: occupancy query reports %d workgroups per CU\n", per_cu);
        (void)hipGetLastError();
        grid = 256;
    }
    if (grid < 0) return;
    if (hipMemsetAsync((char*)d_ws + WS_CTL, 0, CTL_ZERO_BYTES, stream) != hipSuccess) { fprintf(stderr, "kernel_launch: memset failed\n"); return; }
    Args a{};
    for (int i = 0; i < 16; ++i) a.in[i] = (const float*)d_in[i];
    a.out = (float*)d_out; a.ws = (unsigned char*)d_ws;
#if MK_N_LAUNCHES == 1
    a.ph_lo = 0; a.ph_hi = N_PHASES; a.li = 0;
    hipLaunchKernelGGL(mk_fwd, dim3(grid), dim3(NWAVES * 64), LDS_BYTES, stream, a);
#else
    for (int p = 0; p < N_PHASES; ++p) { a.ph_lo = p; a.ph_hi = p + 1; a.li = 0; hipLaunchKernelGGL(mk_fwd, dim3(grid), dim3(NWAVES * 64), LDS_BYTES, stream, a); }
#endif
    const hipError_t le = hipPeekAtLastError();
    if (le != hipSuccess) fprintf(stderr, "kernel_launch: launch failed: %s\n", hipGetErrorName(le));
}
```

```cpp
#include <hip/hip_runtime.h>
#include <cstdio>
#include <cstdint>
namespace pg8 {
#define PG8_LAS __attribute__((address_space(3)))
typedef unsigned short bf16_t;
typedef short bf16x8 __attribute__((ext_vector_type(8)));
typedef float f32x4 __attribute__((ext_vector_type(4)));
typedef unsigned u32x4 __attribute__((ext_vector_type(4)));
constexpr int BM = 256, BK = 64, HALF = 128, HTB = HALF * BK * 2  , STAGE_BYTES = 8 * HTB, NXCD = 8, WGM = 8;

__host__ __device__ __forceinline__ int lds_byte(int r, int c) { const int st = (r >> 4) * 2 + (c >> 5), rr = r & 15, cc = c & 31, ob = rr * 64 + cc * 2; return st * 1024 + (ob ^ (((ob >> 9) & 1) << 5)); }
__host__ __device__ __forceinline__ void stage_rc(int b, int& R, int& C) { const int st = b / 1024, sb = b % 1024, swz = sb ^ (((sb >> 9) & 1) << 5); R = (st >> 1) * 16 + swz / 64; C = (st & 1) * 32 + (swz % 64) / 2; }
__host__ __device__ __forceinline__ int perm32(int rho) { const int n = rho >> 4, i = rho & 15; return 8 * (i >> 2) + 4 * n + (i & 3); }

struct Unit { int pm, pn; };
struct Gemm { const bf16_t* A; const bf16_t* Bt; int M, N, K; };

struct StaticOrder {
    int nM, nN, nwg, G, c;
    __host__ __device__ void init(int M, int N, int G_, int c_) { nM = M / BM; nN = N / BM; nwg = nM * nN; G = G_; c = c_; }
    __host__ __device__ bool next(int i, Unit& u) const {
        const long L = (long)i * G + c; if (L >= nwg) return false;
        int wgid = (int)L; { const int q = nwg / NXCD, r = nwg % NXCD, xcd = wgid % NXCD, off = wgid / NXCD; wgid = (xcd < r ? xcd * (q + 1) : r * (q + 1) + (xcd - r) * q) + off; }
        const int nig = WGM * nN, gid = wgid / nig, fm = gid * WGM, gsz = (nM - fm) < WGM ? (nM - fm) : WGM;
        u.pm = fm + ((wgid % nig) % gsz); u.pn = (wgid % nig) / gsz; return true;
    }
    __device__ __forceinline__ void a_ready(const Unit&) const {}
    __device__ __forceinline__ void done(const Unit&) const {}
};

struct PanelOrder {
    int pm, pn0, nr;
    __device__ __forceinline__ void init(int N, int c) { pm = ((c & 7) << 3) | ((c >> 3) & 7); pn0 = c >> 6; nr = (N / BM) / 4; }
    __device__ __forceinline__ bool next(int i, Unit& u) const { if (i >= nr) return false; u.pm = pm; u.pn = pn0 + 4 * i; return true; }
    __device__ __forceinline__ void a_ready(const Unit&) const {}
    __device__ __forceinline__ void done(const Unit&) const {}
};

typedef __bf16 bf16x2_native __attribute__((ext_vector_type(2)));
typedef float f32x2_native __attribute__((ext_vector_type(2)));
__device__ __forceinline__ unsigned cvt_pk_bf16_native(float lo, float hi) { const f32x2_native v = {lo, hi}; return __builtin_bit_cast(unsigned, __builtin_convertvector(v, bf16x2_native)); }
__device__ __forceinline__ unsigned cvt_pk_bf16(float lo, float hi) { unsigned r; asm volatile("v_cvt_pk_bf16_f32 %0, %1, %2" : "=v"(r) : "v"(lo), "v"(hi)); return r; }
__device__ __forceinline__ int fresh_tid() { int t = threadIdx.x; asm volatile("" : "+v"(t)); return t; }
#define PG8_FRESH_LANE() const int tz_ = fresh_tid(); const int wid_ = tz_ >> 6, lane_ = tz_ & 63; wr = wid_ >> 2; wc = wid_ & 3; fr = lane_ & 15; fq = lane_ >> 4;
typedef float f32x2 __attribute__((ext_vector_type(2)));
__device__ __forceinline__ f32x2 gelu_pk(f32x2 v) {
    const f32x2 av = __builtin_elementwise_abs(v), d = av * 0.2316418882f + 1.0f;
    f32x2 t; t.x = __builtin_amdgcn_rcpf(d.x); t.y = __builtin_amdgcn_rcpf(d.y);
    f32x2 q = t * 0.5307027145f + (-0.7265760135f); q = q * t + 0.7107068705f; q = q * t + (-0.142248368f); q = q * t + 0.127414796f; q = q * t;
    const f32x2 s = (v * v) * (-0.72134752044f);
    f32x2 e; e.x = __builtin_amdgcn_exp2f(s.x); e.y = __builtin_amdgcn_exp2f(s.y);
    const f32x2 m = v * (q * e), r = v - m;
    f32x2 o; o.x = v.x < 0.f ? m.x : r.x; o.y = v.y < 0.f ? m.y : r.y; return o;
}
__device__ __forceinline__ u32x4 pack8(const f32x4 v0, const f32x4 v1) { u32x4 w; w.x = cvt_pk_bf16(v0[0], v0[1]); w.y = cvt_pk_bf16(v0[2], v0[3]); w.z = cvt_pk_bf16(v1[0], v1[1]); w.w = cvt_pk_bf16(v1[2], v1[3]); return w; }

struct EpiGelu {
    static constexpr bool PERM = true, AFTER_DRAIN = false;
    bf16_t* O; int ldc; f32x2* vstat;
    __device__ __forceinline__ void operator()(const f32x4 (&acc)[2][2][4][2], const Unit& u, int wr, int wc, int fr, int fq) const {
        PG8_FRESH_LANE();
        const int row0 = u.pm * BM + wr * 64 + fr, col0 = u.pn * BM + wc * 32 + 8 * fq;
        const bool st = u.pn >= 16;
#pragma unroll
        for (int ai = 0; ai < 2; ++ai)
#pragma unroll
            for (int m = 0; m < 4; ++m) { const int r = row0 + ai * HALF + m * 16; bf16_t* rowp = O + (size_t)r * ldc + col0; float s1 = 0.f, s2 = 0.f;
#pragma unroll
                for (int bj = 0; bj < 2; ++bj) { f32x4 v0 = acc[ai][bj][m][0], v1 = acc[ai][bj][m][1];
                    const f32x2 a = gelu_pk((f32x2){v0[0], v0[1]}), b = gelu_pk((f32x2){v0[2], v0[3]}), c = gelu_pk((f32x2){v1[0], v1[1]}), d = gelu_pk((f32x2){v1[2], v1[3]});
                    v0 = (f32x4){a.x, a.y, b.x, b.y}; v1 = (f32x4){c.x, c.y, d.x, d.y};
                    s1 += ((v0[0] + v0[1]) + (v0[2] + v0[3])) + ((v1[0] + v1[1]) + (v1[2] + v1[3]));
                    s2 += ((v0[0] * v0[0] + v0[1] * v0[1]) + (v0[2] * v0[2] + v0[3] * v0[3])) + ((v1[0] * v1[0] + v1[1] * v1[1]) + (v1[2] * v1[2] + v1[3] * v1[3]));
                    *(u32x4*)(rowp + bj * HALF) = pack8(v0, v1); }
                s1 += __shfl_xor(s1, 16); s1 += __shfl_xor(s1, 32); s2 += __shfl_xor(s2, 16); s2 += __shfl_xor(s2, 32);
                if (st && fq == 0) vstat[((size_t)r * 16 + (u.pn - 16)) * 4 + wc] = (f32x2){s1, s2}; }
    }
};
template <bool XF32> struct EpiResid {
    static constexpr bool PERM = true, AFTER_DRAIN = false;
    const float* xres; bf16_t* hb; float* hstat;
    __device__ __forceinline__ void operator()(const f32x4 (&acc)[2][2][4][2], const Unit& u, int wr, int wc, int fr, int fq) const {
        PG8_FRESH_LANE();
        const int row0 = u.pm * BM + wr * 64 + fr, col0 = u.pn * BM + wc * 32 + 8 * fq;
#pragma unroll
        for (int g = 0; g < 8; ++g) { const int ai = g >> 2, m = g & 3;
            const int r = row0 + ai * HALF + m * 16; const size_t off = (size_t)r * 4096 + col0; float s2 = 0.f;
            f32x4 r0[2], r1[2];
#pragma unroll
            for (int bj = 0; bj < 2; ++bj) {
                if (XF32) { r0[bj] = *(const f32x4*)(xres + off + bj * HALF); r1[bj] = *(const f32x4*)(xres + off + bj * HALF + 4); }
                else { const u32x4 w = *(const u32x4*)(hb + off + bj * HALF);
                    r0[bj] = (f32x4){__builtin_bit_cast(float, w.x << 16), __builtin_bit_cast(float, w.x & 0xffff0000u), __builtin_bit_cast(float, w.y << 16), __builtin_bit_cast(float, w.y & 0xffff0000u)};
                    r1[bj] = (f32x4){__builtin_bit_cast(float, w.z << 16), __builtin_bit_cast(float, w.z & 0xffff0000u), __builtin_bit_cast(float, w.w << 16), __builtin_bit_cast(float, w.w & 0xffff0000u)}; } }
#pragma unroll
            for (int bj = 0; bj < 2; ++bj) { const f32x4 v0 = acc[ai][bj][m][0] + r0[bj], v1 = acc[ai][bj][m][1] + r1[bj];
                s2 += ((v0[0] * v0[0] + v0[1] * v0[1]) + (v0[2] * v0[2] + v0[3] * v0[3])) + ((v1[0] * v1[0] + v1[1] * v1[1]) + (v1[2] * v1[2] + v1[3] * v1[3]));
                *(u32x4*)(hb + off + bj * HALF) = pack8(v0, v1); }
            s2 += __shfl_xor(s2, 16); s2 += __shfl_xor(s2, 32);
            if (fq == 0) hstat[((size_t)r * 16 + u.pn) * 4 + wc] = s2;
            asm volatile("" ::: "memory"); }
    }
};
template <bool SQ> struct EpiScale {
    static constexpr bool PERM = true, AFTER_DRAIN = false;
    bf16_t* O; int ldc; const PG8_LAS float* rs;
    __device__ __forceinline__ void operator()(const f32x4 (&acc)[2][2][4][2], const Unit& u, int wr, int wc, int fr, int fq) const {
        PG8_FRESH_LANE();
        const int rl0 = wr * 64 + fr, col0 = u.pn * BM + wc * 32 + 8 * fq;
#pragma unroll
        for (int ai = 0; ai < 2; ++ai)
#pragma unroll
            for (int m = 0; m < 4; ++m) { const int rl = rl0 + ai * HALF + m * 16; const float sc = rs[rl]; bf16_t* rowp = O + (size_t)(u.pm * BM + rl) * ldc + col0;
#pragma unroll
                for (int bj = 0; bj < 2; ++bj) { f32x4 v0 = acc[ai][bj][m][0] * sc, v1 = acc[ai][bj][m][1] * sc;
                    if (SQ) {
#pragma unroll
                        for (int j = 0; j < 4; ++j) { const float a = fmaxf(v0[j], 0.f), b = fmaxf(v1[j], 0.f); v0[j] = a * a; v1[j] = b * b; } }
                    *(u32x4*)(rowp + bj * HALF) = pack8(v0, v1); } }
    }
};
template <class Epi, class Sched, bool ALIGN_EPI = false, bool SP2 = false>
__device__ __forceinline__ void gemm_phase(PG8_LAS unsigned char* lds, const Gemm g, const Sched& S, const Epi& E) {
    const int tid = threadIdx.x, wid = __builtin_amdgcn_readfirstlane(tid >> 6), lane = tid & 63, wr = wid >> 2, wc = wid & 3, fr = lane & 15, fq = lane >> 4;
    const int K = g.K, nt = K / BK;
    unsigned voffA[2], voffB[2];
#pragma unroll
    for (int i = 0; i < 2; ++i) { int R, C; stage_rc(tid * 16 + i * 8192, R, C); const int Rb = Epi::PERM ? ((R & ~31) + perm32(R & 31)) : R;
        voffA[i] = (unsigned)(R * K + C) * 2u; voffB[i] = (unsigned)(Rb * K + C) * 2u; }
    const size_t kstep = (size_t)(BK * 2);
    const size_t hstep = (size_t)HALF * K * 2;
    const size_t tstep = 2 * hstep;
    const unsigned ldsw = (unsigned)wid * 1024u;
    const int aoff = lds_byte(wr * 64 + fr, fq * 8), boff = lds_byte(wc * 32 + fr, fq * 8);
#define PG8_SA(b, h) (((b) * 2 + (h)) * HTB)
#define PG8_SB(b, h) ((4 + (b) * 2 + (h)) * HTB)
#define PG8_STAGE(bufoff, gbase, voff) do { _Pragma("unroll") for (int _i = 0; _i < 2; ++_i) \
        __builtin_amdgcn_global_load_lds((const unsigned*)((const char*)(gbase) + (voff)[_i]), (PG8_LAS unsigned*)(lds + (bufoff) + ldsw + _i * 8192), 16, 0, 0); } while (0)
#define PG8_LDA(dst, b, h) do { _Pragma("unroll") for (int m = 0; m < 4; ++m) _Pragma("unroll") for (int k = 0; k < 2; ++k) dst[m][k] = *(const PG8_LAS bf16x8*)(lds + PG8_SA(b, h) + aoff + m * 2048 + k * 1024); } while (0)
#define PG8_LDB(dst, b, h) do { _Pragma("unroll") for (int n = 0; n < 2; ++n) _Pragma("unroll") for (int k = 0; k < 2; ++k) dst[n][k] = *(const PG8_LAS bf16x8*)(lds + PG8_SB(b, h) + boff + n * 2048 + k * 1024); } while (0)
#define PG8_MMA(ai, bj, At, Bt) do { __builtin_amdgcn_s_setprio(1); _Pragma("unroll") for (int m = 0; m < 4; ++m) _Pragma("unroll") for (int n = 0; n < 2; ++n) _Pragma("unroll") for (int k = 0; k < 2; ++k) \
        acc[ai][bj][m][n] = __builtin_amdgcn_mfma_f32_16x16x32_bf16(Bt[n][k], At[m][k], acc[ai][bj][m][n], 0, 0, 0); __builtin_amdgcn_s_setprio(0); } while (0)
#define PG8_WAIT_V(n) asm volatile("s_waitcnt vmcnt(" #n ")" ::: "memory")
#define PG8_WAIT_L(n) asm volatile("s_waitcnt lgkmcnt(" #n ")" ::: "memory")
#define PG8_BAR __builtin_amdgcn_s_barrier()
#define PG8_SCHED __builtin_amdgcn_sched_barrier(0)
    Unit cur, nxt; int ui = 0;
    if (!S.next(0, cur)) return;
    f32x4 acc[2][2][4][2];
#pragma unroll
    for (int a = 0; a < 2; ++a)
#pragma unroll
        for (int b = 0; b < 2; ++b)
#pragma unroll
            for (int m = 0; m < 4; ++m)
#pragma unroll
                for (int n = 0; n < 2; ++n) acc[a][b][m][n] = (f32x4){0.f, 0.f, 0.f, 0.f};
    bf16x8 At[4][2], B0[2][2], B1[2][2];
    const char* cA = (const char*)g.A + (size_t)cur.pm * tstep; const char* cB = (const char*)g.Bt + (size_t)cur.pn * tstep;
    S.a_ready(cur);
    if constexpr (SP2) {
        PG8_STAGE(PG8_SB(0, 0), cB, voffB); PG8_STAGE(PG8_SB(0, 1), cB + hstep, voffB); PG8_STAGE(PG8_SA(0, 0), cA, voffA); PG8_STAGE(PG8_SA(0, 1), cA + hstep, voffA);
        if (wr == 1) PG8_BAR;
        PG8_WAIT_V(2); PG8_BAR;
        PG8_STAGE(PG8_SB(1, 0), cB + kstep, voffB); PG8_STAGE(PG8_SA(1, 0), cA + kstep, voffA); PG8_STAGE(PG8_SB(1, 1), cB + hstep + kstep, voffB);
        PG8_WAIT_V(6); PG8_BAR;
    } else {
        PG8_STAGE(PG8_SB(0, 0), cB, voffB); PG8_STAGE(PG8_SA(0, 0), cA, voffA); PG8_STAGE(PG8_SB(0, 1), cB + hstep, voffB); PG8_STAGE(PG8_SA(0, 1), cA + hstep, voffA);
        if (wr == 1) PG8_BAR;
        PG8_WAIT_V(4); PG8_BAR;
        PG8_STAGE(PG8_SB(1, 0), cB + kstep, voffB); PG8_STAGE(PG8_SA(1, 0), cA + kstep, voffA); PG8_STAGE(PG8_SB(1, 1), cB + hstep + kstep, voffB);
        PG8_WAIT_V(6); PG8_BAR;
    }
    for (;;) {
        const bool has_next = S.next(ui + 1, nxt);
        const char* nA = has_next ? (const char*)g.A + (size_t)nxt.pm * tstep : cA; const char* nB = has_next ? (const char*)g.Bt + (size_t)nxt.pn * tstep : cB;
        for (int t = 0; t < nt; t += 2) {
            const bool last = (t == nt - 2);
            const char* a1 = cA + (size_t)(t + 1) * kstep;
            const char* a2 = last ? nA : cA + (size_t)(t + 2) * kstep; const char* b2 = last ? nB : cB + (size_t)(t + 2) * kstep;
            const char* a3 = a2 + kstep; const char* b3 = b2 + kstep;
            if (last && has_next) S.a_ready(nxt);
            if constexpr (SP2) {
            PG8_LDB(B0, 0, 0); PG8_LDB(B1, 0, 1); PG8_SCHED; PG8_LDA(At, 0, 0); PG8_STAGE(PG8_SA(1, 1), a1 + hstep, voffA);
            PG8_WAIT_V(8); PG8_WAIT_L(0); PG8_BAR; PG8_MMA(0, 0, At, B0); PG8_MMA(0, 1, At, B1); PG8_BAR; PG8_SCHED;
            PG8_LDA(At, 0, 1); PG8_STAGE(PG8_SB(0, 0), b2, voffB); PG8_STAGE(PG8_SB(0, 1), b2 + hstep, voffB); PG8_STAGE(PG8_SA(0, 0), a2, voffA);
            PG8_WAIT_V(8); PG8_WAIT_L(0); PG8_BAR; PG8_MMA(1, 0, At, B0); PG8_MMA(1, 1, At, B1); PG8_BAR; PG8_SCHED;
            PG8_LDB(B0, 1, 0); PG8_LDB(B1, 1, 1); PG8_SCHED; PG8_LDA(At, 1, 0); PG8_STAGE(PG8_SA(0, 1), a2 + hstep, voffA);
            PG8_WAIT_V(8); PG8_WAIT_L(0); PG8_BAR; PG8_MMA(0, 0, At, B0); PG8_MMA(0, 1, At, B1); PG8_BAR; PG8_SCHED;
            PG8_LDA(At, 1, 1); PG8_STAGE(PG8_SB(1, 0), b3, voffB); PG8_STAGE(PG8_SB(1, 1), b3 + hstep, voffB); PG8_STAGE(PG8_SA(1, 0), a3, voffA);
            PG8_WAIT_V(8); PG8_WAIT_L(0); PG8_BAR; PG8_MMA(1, 0, At, B0); PG8_MMA(1, 1, At, B1); PG8_BAR; PG8_SCHED;
            } else {
            PG8_LDB(B0, 0, 0); PG8_SCHED; PG8_LDA(At, 0, 0); PG8_STAGE(PG8_SA(1, 1), a1 + hstep, voffA);
            PG8_WAIT_L(8); PG8_BAR; PG8_WAIT_L(0); PG8_MMA(0, 0, At, B0); PG8_BAR; PG8_SCHED;
            PG8_LDB(B1, 0, 1); PG8_STAGE(PG8_SB(0, 0), b2, voffB);
            PG8_BAR; PG8_WAIT_L(0); PG8_MMA(0, 1, At, B1); PG8_BAR;
            PG8_LDA(At, 0, 1); PG8_STAGE(PG8_SA(0, 0), a2, voffA);
            PG8_BAR; PG8_WAIT_L(0); PG8_MMA(1, 0, At, B0); PG8_BAR; PG8_SCHED;
            PG8_STAGE(PG8_SB(0, 1), b2 + hstep, voffB);
            PG8_WAIT_V(6); PG8_BAR; PG8_MMA(1, 1, At, B1); PG8_BAR;
            PG8_LDB(B0, 1, 0); PG8_SCHED; PG8_LDA(At, 1, 0); PG8_STAGE(PG8_SA(0, 1), a2 + hstep, voffA);
            PG8_WAIT_L(8); PG8_BAR; PG8_WAIT_L(0); PG8_MMA(0, 0, At, B0); PG8_BAR; PG8_SCHED;
            PG8_LDB(B1, 1, 1); PG8_STAGE(PG8_SB(1, 0), b3, voffB);
            PG8_BAR; PG8_WAIT_L(0); PG8_MMA(0, 1, At, B1); PG8_BAR;
            PG8_LDA(At, 1, 1); PG8_STAGE(PG8_SA(1, 0), a3, voffA);
            PG8_BAR; PG8_WAIT_L(0); PG8_MMA(1, 0, At, B0); PG8_BAR; PG8_SCHED;
            PG8_STAGE(PG8_SB(1, 1), b3 + hstep, voffB);
            PG8_WAIT_V(6); PG8_BAR; PG8_MMA(1, 1, At, B1); PG8_BAR;
            }
        }
        if constexpr (ALIGN_EPI) { if (wr == 0) PG8_BAR; }
        if constexpr (!Epi::AFTER_DRAIN) { E(acc, cur, wr, wc, fr, fq); S.done(cur); }
        if (!has_next) break;
#pragma unroll
        for (int a = 0; a < 2; ++a)
#pragma unroll
            for (int b = 0; b < 2; ++b)
#pragma unroll
                for (int m = 0; m < 4; ++m)
#pragma unroll
                    for (int n = 0; n < 2; ++n) acc[a][b][m][n] = (f32x4){0.f, 0.f, 0.f, 0.f};
        cur = nxt; cA = nA; cB = nB; ++ui;
        if constexpr (ALIGN_EPI) { if (wr == 1) PG8_BAR; }
    }
    PG8_WAIT_V(0);
    if constexpr (!ALIGN_EPI) { if (wr == 0) PG8_BAR; }
    PG8_BAR;
    if constexpr (Epi::AFTER_DRAIN) { E.fused(acc, cur, wr, wc, fr, fq, lds, wid, lane); S.done(cur); }
#undef PG8_SA
#undef PG8_SB
#undef PG8_STAGE
#undef PG8_LDA
#undef PG8_LDB
#undef PG8_MMA
#undef PG8_WAIT_V
#undef PG8_WAIT_L
#undef PG8_BAR
#undef PG8_SCHED
}
}

constexpr int NWAVES = 8;
constexpr int BATCH = 4, SEQ = 4096, D = 4096, M = BATCH * SEQ, FF = 4 * D;
constexpr int NZ = 2 * D;
constexpr int HEADS = 8, DK = 256, DV = 512, CH = 128, NCH = SEQ / CH;
constexpr int NP = 2 * HEADS * DK + 2 * HEADS * DV;
constexpr int ML_IN = NP + 2 * HEADS;
constexpr float EPS = 1e-6f;
constexpr float GATE_CAP = 15.0f;
#ifndef MK_N_LAUNCHES
#define MK_N_LAUNCHES 1
#endif
constexpr int N_PHASES = 13;

constexpr size_t MiB = 1u << 20;
constexpr size_t WS_CTL = 0, CTL_ZERO_BYTES = 1 * MiB;
constexpr size_t WS_VSTAT = 1 * MiB;
constexpr size_t WS_HSTAT = 9 * MiB;
constexpr size_t WS_HSSTAT = 13 * MiB;
constexpr size_t WS_GATES = 17 * MiB;
constexpr size_t WS_W1 = 32 * MiB;
constexpr size_t WS_W2 = 96 * MiB;
constexpr size_t WS_WUP0 = 128 * MiB;
constexpr size_t WS_WDN0 = 256 * MiB;
constexpr size_t WS_WML = 384 * MiB;
constexpr size_t WS_WMO = 481 * MiB;
constexpr size_t WS_WUP1 = 513 * MiB;
constexpr size_t WS_WDN1 = 641 * MiB;
constexpr size_t WS_HB = 769 * MiB;
constexpr size_t WS_R = 897 * MiB;
constexpr size_t WS_XB = WS_R, WS_Z = WS_R + 128 * MiB, WS_GATED = WS_R + 384 * MiB;
constexpr size_t WS_A = WS_R;
constexpr size_t WS_PROJ = WS_R, WS_HS = WS_R + 384 * MiB;
constexpr size_t WS_END = WS_R + 512 * MiB;
static_assert(WS_WML + (size_t)ML_IN * D * 2 <= WS_WMO, "ws map");
constexpr int CW_BAR = 4096;

constexpr int RING_BYTES = 131072;
constexpr int RS_OFF = RING_BYTES;
constexpr int LDS_BYTES = 147456;
constexpr int MISC_OFF = LDS_BYTES - 256;

#define LAS __attribute__((address_space(3)))
typedef unsigned short bf16;
typedef unsigned v4u __attribute__((ext_vector_type(4)));
typedef unsigned v2u __attribute__((ext_vector_type(2)));
typedef float f32x4 __attribute__((ext_vector_type(4)));
typedef float f32x2 __attribute__((ext_vector_type(2)));
typedef short bf16x8 __attribute__((ext_vector_type(8)));
typedef short s16x4 __attribute__((ext_vector_type(4)));
#define LDS_WAIT() asm volatile("s_waitcnt lgkmcnt(0)" ::: "memory")
__device__ __forceinline__ unsigned f2bf(float f) { unsigned u = __builtin_bit_cast(unsigned, f); return (u + 0x7fffu + ((u >> 16) & 1u)) >> 16; }
__device__ __forceinline__ unsigned pk2(float lo, float hi) { return pg8::cvt_pk_bf16(lo, hi); }
__device__ __forceinline__ unsigned pk2n(float lo, float hi) { return pg8::cvt_pk_bf16_native(lo, hi); }
__device__ __forceinline__ float bf_lo(unsigned u) { return __builtin_bit_cast(float, u << 16); }
__device__ __forceinline__ float bf_hi(unsigned u) { return __builtin_bit_cast(float, u & 0xffff0000u); }
__device__ __forceinline__ float wave_sum(float v) {
#pragma unroll
    for (int o = 1; o < 64; o <<= 1) v += __shfl_xor(v, o);
    return v;
}
#define XB_TMO      128
#define XB_XCNT(j)  (256  + 64 * (j))
#define XB_XSUB(j)  (1280 + 64 * (j))
#define XB_XGEN(j)  (2304 + 64 * (j))
#define XB_TOP      3328
#define XB_TOPGEN   3392
#define XCD_BAR_WORDS 3456
#define XB_SPIN_CAP (1u << 18)

__device__ __forceinline__ unsigned xb_ld(unsigned* p)              { return __hip_atomic_load(p, __ATOMIC_RELAXED, __HIP_MEMORY_SCOPE_AGENT); }
__device__ __forceinline__ unsigned xb_add(unsigned* p, unsigned v) { return __hip_atomic_fetch_add(p, v, __ATOMIC_RELAXED, __HIP_MEMORY_SCOPE_AGENT); }
__device__ __forceinline__ unsigned xb_xcc_id() { return (unsigned)__builtin_amdgcn_s_getreg((3 << 11) | 20) & 0xFu; }
#define XB_SPIN(cond, bar) do { unsigned _sp = 0; while (cond) { __builtin_amdgcn_s_sleep(1); \
    if ((++_sp & 255u) == 0u) { if (xb_ld(&(bar)[XB_TMO])) break; if (_sp > XB_SPIN_CAP) { atomicAdd(&(bar)[XB_TMO], 1u); break; } } } } while (0)

struct XcdBarrier {
    unsigned* bar; unsigned x;
    volatile LAS unsigned* st;
};

__device__ __forceinline__ XcdBarrier xcd_barrier_post(unsigned* bar, volatile LAS unsigned* st) {
    XcdBarrier b; b.bar = bar; b.x = xb_xcc_id(); b.st = st;
    if (threadIdx.x == 0) (void)xb_add(&bar[XB_XCNT(b.x)], 1u);
    return b;
}
__device__ __forceinline__ void xcd_barrier_complete(unsigned* bar, unsigned x, unsigned& nloc, unsigned& nx) {
    const unsigned G = gridDim.x * gridDim.y * gridDim.z;
    unsigned sum, cnt, mine, sp = 0u;
    for (;;) {
        sum = 0u; cnt = 0u; mine = 0u;
#pragma unroll
        for (unsigned j = 0; j < 16; ++j) { const unsigned c = xb_ld(&bar[XB_XCNT(j)]); sum += c; cnt += (c > 0u) ? 1u : 0u; mine = (j == x) ? c : mine; }
        if (sum == G) break;
        __builtin_amdgcn_s_sleep(1);
        if ((++sp & 255u) == 0u) { if (xb_ld(&bar[XB_TMO])) break; if (sp > XB_SPIN_CAP) { atomicAdd(&bar[XB_TMO], 1u); break; } }
    }
    nloc = mine > 0u ? mine : 1u; nx = cnt > 0u ? cnt : 1u;
}

__device__ __forceinline__ void xcd_barrier(const XcdBarrier& b) {
    asm volatile("s_waitcnt vmcnt(0)" ::: "memory");
    __syncthreads();
    if (threadIdx.x == 0) {
        unsigned* bar = b.bar;
        __builtin_amdgcn_s_waitcnt(0);
        unsigned nloc = b.st[0], nx = b.st[1];
        if (nloc == 0u) { xcd_barrier_complete(bar, b.x, nloc, nx); b.st[0] = nloc; b.st[1] = nx; }
        const unsigned old = xb_add(&bar[XB_XSUB(b.x)], 1u);
        const unsigned gen = old / nloc;
        if (old + 1u == (gen + 1u) * nloc) {
            __builtin_amdgcn_fence(__ATOMIC_RELEASE, "agent");
            asm volatile("s_waitcnt vmcnt(0)" ::: "memory");
            const unsigned og = xb_add(&bar[XB_TOP], 1u);
            const unsigned tg = og / nx;
            if (og + 1u == (tg + 1u) * nx) xb_add(&bar[XB_TOPGEN], 1u);
            else XB_SPIN(xb_ld(&bar[XB_TOPGEN]) == tg, bar);
            __builtin_amdgcn_fence(__ATOMIC_ACQUIRE, "agent");
            xb_add(&bar[XB_XGEN(b.x)], 1u);
            asm volatile("s_waitcnt vmcnt(0)" ::: "memory");
        } else {
            XB_SPIN(xb_ld(&bar[XB_XGEN(b.x)]) == gen, bar);
            __builtin_amdgcn_fence(__ATOMIC_ACQUIRE, "agent");
            asm volatile("s_waitcnt vmcnt(0)" ::: "memory");
        }
    }
    __syncthreads();
}

__device__ __forceinline__ void p0_transpose_item(const float* __restrict__ W, int Nsrc, int K, int k0, int n0, int ncols, const float* __restrict__ gk, float cs,
                                                  bf16* __restrict__ WT, LAS float* scr, int lane) {
    const int nq = lane & 15, kh = lane >> 4;
    const bool okc = 4 * nq < ncols;
    f32x4 v[16];
    const float* src = W + (size_t)(k0 + kh) * Nsrc + n0 + 4 * nq;
#pragma unroll
    for (int i = 0; i < 16; ++i) v[i] = okc ? __builtin_nontemporal_load((const f32x4*)(src + (size_t)(4 * i) * Nsrc)) : (f32x4){0.f, 0.f, 0.f, 0.f};
    const int c = lane & 7;
    f32x4 g0 = {cs, cs, cs, cs}, g1 = {cs, cs, cs, cs};
    if (gk) { g0 = *(const f32x4*)(gk + k0 + 8 * c) * cs; g1 = *(const f32x4*)(gk + k0 + 8 * c + 4) * cs; }
#pragma unroll
    for (int i = 0; i < 16; ++i) { const int kk = 4 * i + kh; *(LAS f32x4*)(scr + kk * 64 + ((4 * nq) ^ (4 * ((kk >> 3) & 7)))) = v[i]; }
    LDS_WAIT(); asm volatile("" ::: "memory");
#pragma unroll
    for (int j = 0; j < 8; ++j) { const int n = (lane >> 3) + 8 * j; const LAS float* sp = scr + (8 * c) * 64 + (n ^ (4 * c));
        v4u o; o.x = pk2(sp[0 * 64] * g0.x, sp[1 * 64] * g0.y); o.y = pk2(sp[2 * 64] * g0.z, sp[3 * 64] * g0.w); o.z = pk2(sp[4 * 64] * g1.x, sp[5 * 64] * g1.y); o.w = pk2(sp[6 * 64] * g1.z, sp[7 * 64] * g1.w);
        if (n < ncols) *(v4u*)(WT + (size_t)(n0 + n) * K + k0 + 8 * c) = o; }
    LDS_WAIT(); asm volatile("" ::: "memory");
}
struct WConv { const float* W; const float* gk; bf16* WT; int K, Nsrc; };
__device__ __forceinline__ void p0_convert(const WConv& w, int item, LAS float* scr, int lane, int qcols) {
    const int nnb = (w.Nsrc + 63) / 64, kb = item / nnb, nb = item - kb * nnb, n0 = nb * 64;
    const int ncols = (w.Nsrc - n0) < 64 ? (w.Nsrc - n0) : 64;
    p0_transpose_item(w.W, w.Nsrc, w.K, kb * 64, n0, ncols, w.gk, n0 < qcols ? 0.0625f : 1.0f, w.WT, scr, lane);
}
__device__ __forceinline__ void p0_xrow(const float* __restrict__ xrow, const float* __restrict__ g, bf16* __restrict__ orow, int lane) {
    const f32x4* xr = (const f32x4*)xrow + lane; const f32x4* gr = (const f32x4*)g + lane;
    f32x4 v[16]; float s = 0.f;
#pragma unroll
    for (int j = 0; j < 16; ++j) { v[j] = __builtin_nontemporal_load(xr + 64 * j); s += (v[j].x * v[j].x + v[j].y * v[j].y) + (v[j].z * v[j].z + v[j].w * v[j].w); }
    const float rstd = 1.0f / sqrtf(wave_sum(s) * (1.f / D) + EPS);
    v2u* o8 = (v2u*)orow + lane;
#pragma unroll
    for (int j = 0; j < 16; ++j) { const f32x4 gg = gr[64 * j]; v2u o; o.x = pk2(v[j].x * rstd * gg.x, v[j].y * rstd * gg.y); o.y = pk2(v[j].z * rstd * gg.z, v[j].w * rstd * gg.w); o8[64 * j] = o; }
}

__device__ __forceinline__ void load_rstd_table(LAS float* rs, const float* __restrict__ hstat, int pm, int tid) {
    const int row = tid >> 1, half = tid & 1;
    const f32x4* p = (const f32x4*)(hstat + ((size_t)(pm * 256 + row) * 64 + half * 32));
    float s = 0.f;
#pragma unroll
    for (int j = 0; j < 8; ++j) { const f32x4 v = p[j]; s += (v.x + v.y) + (v.z + v.w); }
    s += __shfl_xor(s, 1);
    if (half == 0) rs[row] = 1.0f / sqrtf(s * (1.f / D) + EPS);
    LDS_WAIT(); __syncthreads();
}

__device__ __forceinline__ int img_off(int row, int ch) { return 256 * row + 16 * (ch ^ (((row & 3) << 2) | ((row >> 2) & 3))); }
__device__ __forceinline__ void p2_spatial(LAS unsigned char* lds, const bf16* __restrict__ z, const f32x2* __restrict__ vstat, const float* __restrict__ lng, const float* __restrict__ lnb,
                                           const float* __restrict__ ws_, const float* __restrict__ bs_, bf16* __restrict__ gated, int c, int tid0) {
    LAS unsigned char* Wimg = lds;
    LAS unsigned char* Vimg = lds + 32768;
    LAS float* mu = (LAS float*)(lds + 131072);
    LAS float* rsd = mu + 256;
    const int pm = ((c & 7) << 3) | ((c >> 3) & 7), sub = c >> 6;
    const int w = __builtin_amdgcn_readfirstlane(tid0 >> 6), jq = w & 3, th = w >> 2;
    __syncthreads();
    { const int row = tid0 >> 1, part = tid0 & 1;
      const f32x4* p = (const f32x4*)(vstat + ((size_t)(pm * 256 + row) * 64 + part * 32));
      float s1 = 0.f, s2 = 0.f;
#pragma unroll
      for (int j = 0; j < 16; ++j) { const f32x4 v = p[j]; s1 += v.x + v.z; s2 += v.y + v.w; }
      s1 += __shfl_xor(s1, 1); s2 += __shfl_xor(s2, 1);
      const float mean = s1 * (1.f / D); const float var = fmaxf(s2 * (1.f / D) - mean * mean, 0.f);
      if (part == 0) { mu[row] = mean; rsd[row] = 1.0f / sqrtf(var + EPS); } }
    v4u raw[8];
#define P2_LOADV(STEP) do { const int hi_ = (STEP) >> 2, cc_ = ((STEP) >> 1) & 1, hf_ = (STEP) & 1; const int tp = pg8::fresh_tid(); \
        const bf16* vp_ = z + (size_t)(pm * 256 + cc_ * 128 + (tp >> 5)) * NZ + D + (2 * sub + hi_) * 512 + hf_ * 256 + 8 * (tp & 31); \
        _Pragma("unroll") for (int it = 0; it < 8; ++it) raw[it] = *(const v4u*)(vp_ + (size_t)(16 * it) * NZ); } while (0)
    P2_LOADV(0);
    for (int step = 0; step < 8; ++step) {
        const int hi = step >> 2, cc = (step >> 1) & 1, hf = step & 1, hh = 2 * sub + hi;
        const int m0 = pm * 256 + cc * 128, j0 = hh * 512 + hf * 256;
        __syncthreads();
        if ((step & 3) == 0) { const int tid = pg8::fresh_tid();
#pragma unroll
          for (int it = 0; it < 4; ++it) { const int p = tid + 512 * it, t = p >> 4, ch = p & 15, s0 = 8 * ch;
              const f32x4 a = *(const f32x4*)(ws_ + ((size_t)hh * 128 + t) * 128 + s0), b = *(const f32x4*)(ws_ + ((size_t)hh * 128 + t) * 128 + s0 + 4);
              v4u o; o.x = pk2(s0 + 0 <= t ? a.x : 0.f, s0 + 1 <= t ? a.y : 0.f); o.y = pk2(s0 + 2 <= t ? a.z : 0.f, s0 + 3 <= t ? a.w : 0.f);
              o.z = pk2(s0 + 4 <= t ? b.x : 0.f, s0 + 5 <= t ? b.y : 0.f); o.w = pk2(s0 + 6 <= t ? b.z : 0.f, s0 + 7 <= t ? b.w : 0.f);
              *(LAS v4u*)(Wimg + img_off(t, ch)) = o; } }
        { const int tid = pg8::fresh_tid();
          const int cg = tid & 31; float g8[8], b8[8];
          { const f32x4 a = *(const f32x4*)(lng + j0 + 8 * cg), b = *(const f32x4*)(lng + j0 + 8 * cg + 4); g8[0] = a.x; g8[1] = a.y; g8[2] = a.z; g8[3] = a.w; g8[4] = b.x; g8[5] = b.y; g8[6] = b.z; g8[7] = b.w; }
          { const f32x4 a = *(const f32x4*)(lnb + j0 + 8 * cg), b = *(const f32x4*)(lnb + j0 + 8 * cg + 4); b8[0] = a.x; b8[1] = a.y; b8[2] = a.z; b8[3] = a.w; b8[4] = b.x; b8[5] = b.y; b8[6] = b.z; b8[7] = b.w; }
#pragma unroll
          for (int it = 0; it < 8; ++it) { const int sr = (tid >> 5) + 16 * it; const float mm = mu[cc * 128 + sr], rr = rsd[cc * 128 + sr];
              float f[8] = {bf_lo(raw[it].x), bf_hi(raw[it].x), bf_lo(raw[it].y), bf_hi(raw[it].y), bf_lo(raw[it].z), bf_hi(raw[it].z), bf_lo(raw[it].w), bf_hi(raw[it].w)};
#pragma unroll
              for (int e = 0; e < 8; ++e) f[e] = (f[e] - mm) * rr * g8[e] + b8[e];
              v4u o; o.x = pk2(f[0], f[1]); o.y = pk2(f[2], f[3]); o.z = pk2(f[4], f[5]); o.w = pk2(f[6], f[7]);
              *(LAS v4u*)(Vimg + ((cg >> 4) << 15) + img_off(sr, cg & 15)) = o; } }
        LDS_WAIT(); __syncthreads();
        if (step + 1 < 8) P2_LOADV(step + 1);
        const int tid = pg8::fresh_tid(), lane = tid & 63, l15 = lane & 15, q = lane >> 4;
        const int nks = 2 * th + 2;
        v2u uu[4][4]; float bsv[4];
#pragma unroll
        for (int tbq = 0; tbq < 4; ++tbq) { const int t = 16 * (4 * th + tbq) + l15; bsv[tbq] = bs_[hh * 128 + t];
#pragma unroll
            for (int jb = 0; jb < 4; ++jb) uu[jb][tbq] = *(const v2u*)(z + (size_t)(m0 + t) * NZ + j0 + 64 * jq + 16 * jb + 4 * q); }
#pragma unroll
        for (int jb = 0; jb < 4; ++jb) {
            const int jbl = 4 * jq + jb, cI = jbl & 7; const LAS unsigned char* vb = Vimg + ((jbl >> 3) << 15);
            bf16x8 Af[4];
#pragma unroll
            for (int ks = 0; ks < 4; ++ks) { if (ks < nks) {
                const int r0 = 32 * ks + 8 * q + (l15 >> 2), c8 = 2 * cI + ((l15 & 3) >> 1);
                const s16x4 t0 = __builtin_amdgcn_ds_read_tr16_b64_v4i16((LAS s16x4*)(vb + img_off(r0, c8) + 8 * (l15 & 1)));
                const s16x4 t1 = __builtin_amdgcn_ds_read_tr16_b64_v4i16((LAS s16x4*)(vb + img_off(r0 + 4, c8) + 8 * (l15 & 1)));
                Af[ks] = (bf16x8){t0[0], t0[1], t0[2], t0[3], t1[0], t1[1], t1[2], t1[3]}; } else Af[ks] = (bf16x8){0, 0, 0, 0, 0, 0, 0, 0}; }
#pragma unroll
            for (int tbq = 0; tbq < 4; ++tbq) {
                const int tb = 4 * th + tbq; f32x4 acc = {0.f, 0.f, 0.f, 0.f};
#pragma unroll
                for (int ks = 0; ks < 4; ++ks) if (2 * ks <= tb) { const bf16x8 bfr = *(const LAS bf16x8*)(Wimg + img_off(16 * tb + l15, 4 * ks + q));
                    acc = __builtin_amdgcn_mfma_f32_16x16x32_bf16(Af[ks], bfr, acc, 0, 0, 0); }
                const int t = 16 * tb + l15, j = j0 + 64 * jq + 16 * jb + 4 * q; const float bb = bsv[tbq]; const v2u u2 = uu[jb][tbq];
                v2u o; o.x = pk2n(bf_lo(u2.x) * (acc[0] + bb), bf_hi(u2.x) * (acc[1] + bb)); o.y = pk2n(bf_lo(u2.y) * (acc[2] + bb), bf_hi(u2.y) * (acc[3] + bb));
                *(v2u*)(gated + (size_t)(m0 + t) * D + j) = o;
            }
        }
    }
#undef P2_LOADV
}

__device__ __forceinline__ void p6_gates(const bf16* __restrict__ hb, const bf16* __restrict__ wg, const LAS float* rs, float* __restrict__ gates, int c, int wave, int lane) {
    if (wave >= 4) return;
    const int pm = ((c & 7) << 3) | ((c >> 3) & 7), sub = c >> 6;
    const int rl0 = 64 * sub + 16 * wave, l15 = lane & 15, q = lane >> 4;
    const bf16* ap = hb + (size_t)(pm * 256 + rl0 + l15) * D + 8 * q;
    const bf16* bp = wg + (size_t)l15 * D + 8 * q;
    f32x4 acc0 = {0.f, 0.f, 0.f, 0.f}, acc1 = {0.f, 0.f, 0.f, 0.f};
#pragma unroll 4
    for (int ks = 0; ks < D / 32; ks += 2) {
        const bf16x8 a0 = *(const bf16x8*)(ap + 32 * ks), b0 = *(const bf16x8*)(bp + 32 * ks);
        const bf16x8 a1 = *(const bf16x8*)(ap + 32 * ks + 32), b1 = *(const bf16x8*)(bp + 32 * ks + 32);
        acc0 = __builtin_amdgcn_mfma_f32_16x16x32_bf16(a0, b0, acc0, 0, 0, 0);
        acc1 = __builtin_amdgcn_mfma_f32_16x16x32_bf16(a1, b1, acc1, 0, 0, 0);
    }
#pragma unroll
    for (int r = 0; r < 4; ++r) { const int rl = rl0 + 4 * q + r; gates[(size_t)(pm * 256 + rl) * 16 + l15] = (acc0[r] + acc1[r]) * rs[rl]; }
}

constexpr int P7_KS = 528, P7_VS = 272, P7_K_OFF = 0, P7_VT_OFF = 65536, P7_CT_OFF = P7_VT_OFF + 80 * P7_VS, P7_VEC_OFF = P7_CT_OFF + 80 * P7_KS;
__device__ __forceinline__ int p7_koff(int row, int dk8  ) { const int ch = dk8 & 15; return ((dk8 >> 4) << 15) + 256 * row + 16 * (ch ^ (((row & 3) << 2) | ((row >> 2) & 3))); }
static_assert(P7_VEC_OFF + 4096 <= MISC_OFF && P7_VT_OFF % 16 == 0 && P7_CT_OFF % 16 == 0 && P7_VEC_OFF % 16 == 0, "P7 LDS map");
template <int ABL = 0> __device__ __forceinline__ void p7_mlstm(LAS unsigned char* lds, const bf16* __restrict__ proj, const float* __restrict__ gates, const float* __restrict__ bgate,
                                         bf16* __restrict__ hs, float* __restrict__ hsstat, float* __restrict__ gsc  , int c, int tid0) {
    const int w = __builtin_amdgcn_readfirstlane(tid0 >> 6);
    const int tb = w < 4 ? w : 11 - w;
    const int xcd = c & 7, y = c >> 3, bh = 8 * (y >> 3) + xcd, sl = y & 7, b = bh >> 3, h = bh & 7;
    LAS unsigned char* Kl = lds + P7_K_OFF; LAS unsigned char* VT = lds + P7_VT_OFF; LAS unsigned char* CT = lds + P7_CT_OFF;
    LAS float* ve = (LAS float*)(lds + P7_VEC_OFF);
    LAS float* vM = ve + 128, *viw = ve + 256, *vfl = ve + 384, *vw = ve + 512, *vsc = ve + 640;
    __syncthreads();
    for (int i = tid0; i < 80 * P7_KS / 4; i += 512) ((LAS unsigned*)CT)[i] = 0u;
    for (int i = tid0; i < 16 * P7_VS / 4; i += 512) ((LAS unsigned*)(VT + 64 * P7_VS))[i] = (i < P7_VS / 4) ? 0x3f803f80u : 0u;
    { const float bi = bgate[h], bfg = bgate[8 + h]; const int lane = tid0 & 63, t0 = 2 * lane;
      for (int ch = w; ch < NCH; ch += 8) { const int m0 = b * SEQ + ch * CH;
          float ip[2], lf[2];
#pragma unroll
          for (int k = 0; k < 2; ++k) { const float gi = gates[(size_t)(m0 + t0 + k) * 16 + h] + bi, gf = gates[(size_t)(m0 + t0 + k) * 16 + 8 + h] + bfg;
              ip[k] = GATE_CAP * tanhf(gi * (1.f / GATE_CAP)); const float fp = GATE_CAP * tanhf(gf * (1.f / GATE_CAP));
              lf[k] = fminf(fp, 0.f) - log1pf(expf(-fabsf(fp))); }
          const float pair = lf[0] + lf[1]; float inc = pair;
#pragma unroll
          for (int o = 1; o < 64; o <<= 1) { const float n = __shfl_up(inc, o); if (lane >= o) inc += n; }
          const float bc0 = (inc - pair) + lf[0], bc1 = inc;
          const float e0 = ip[0] - bc0, e1 = ip[1] - bc1;
          float im = fmaxf(e0, e1);
#pragma unroll
          for (int o = 1; o < 64; o <<= 1) { const float n = __shfl_up(im, o); if (lane >= o) im = fmaxf(im, n); }
          float ex = __shfl_up(im, 1); if (lane == 0) ex = -3.0e38f;
          f32x2* g2 = (f32x2*)(gsc + ch * 384) + lane;
          g2[0] = (f32x2){bc0, bc1}; g2[64] = (f32x2){e0, e1}; g2[128] = (f32x2){fmaxf(ex, e0), im}; } }
    f32x4 accC[2][5];
#pragma unroll
    for (int a = 0; a < 2; ++a)
#pragma unroll
        for (int d = 0; d < 5; ++d) accC[a][d] = (f32x4){0.f, 0.f, 0.f, 0.f};
    float mcar = 0.f;
    v4u idw[2];
#pragma unroll
    for (int kb = 0; kb < 2; ++kb) { const int tgt = 16 * kb + (tid0 & 15) - 8 * ((tid0 & 63) >> 4);
        idw[kb].x = (tgt == 0 ? 0x3f80u : 0u) | (tgt == 1 ? 0x3f800000u : 0u); idw[kb].y = (tgt == 2 ? 0x3f80u : 0u) | (tgt == 3 ? 0x3f800000u : 0u);
        idw[kb].z = (tgt == 4 ? 0x3f80u : 0u) | (tgt == 5 ? 0x3f800000u : 0u); idw[kb].w = (tgt == 6 ? 0x3f80u : 0u) | (tgt == 7 ? 0x3f800000u : 0u); }
    asm volatile("s_waitcnt vmcnt(0)" ::: "memory"); __syncthreads();
    v4u kr[8], vr[2]; bf16x8 Qf[8]; f32x2 gv[3];
#define P7_PREFETCH(CHN) do { const int m0n = b * SEQ + (CHN) * CH; const int tidp = pg8::fresh_tid(), lp = tidp & 63; \
        _Pragma("unroll") for (int it = 0; it < 8; ++it) { const int p = tidp + 512 * it, row = p >> 5, c16 = p & 31; kr[it] = *(const v4u*)(proj + (size_t)(m0n + row) * NP + 2048 + h * DK + 8 * c16); } \
        _Pragma("unroll") for (int it = 0; it < 2; ++it) { const int p = tidp + 512 * it, sidx = p & 127, cg = p >> 7; vr[it] = *(const v4u*)(proj + (size_t)(m0n + sidx) * NP + 4096 + h * DV + sl * 64 + 8 * cg); } \
        { const bf16* qp = proj + (size_t)(m0n + 16 * tb + (lp & 15)) * NP + h * DK + 8 * (lp >> 4); _Pragma("unroll") for (int ks = 0; ks < 8; ++ks) Qf[ks] = *(const bf16x8*)(qp + 32 * ks); } \
        { const f32x2* g2 = (const f32x2*)(gsc + (CHN) * 384) + lp; gv[0] = g2[0]; gv[1] = g2[64]; gv[2] = g2[128]; } } while (0)
    P7_PREFETCH(0);
    for (int ch = 0; ch < NCH; ++ch) {
        const int m0 = b * SEQ + ch * CH;
        const int tid = pg8::fresh_tid(), lane = tid & 63, l15 = lane & 15, q = lane >> 4;
        const int fsw = ((l15 & 3) << 2) | ((l15 >> 2) & 3);
        {
            const int t0 = 2 * lane;
            const float M0 = fmaxf(mcar, gv[2].x), M1 = fmaxf(mcar, gv[2].y);
            const float Ml = __shfl(M1, 63), gl = __shfl(gv[0].y, 63);
            if (w == 0) {
                *(LAS f32x2*)(ve + t0) = gv[1]; *(LAS f32x2*)(vM + t0) = (f32x2){M0, M1};
                *(LAS f32x2*)(viw + t0) = (f32x2){__expf(mcar - M0), __expf(mcar - M1)};
                *(LAS f32x2*)(vfl + t0) = (f32x2){__expf(-gv[0].x - M0), __expf(-gv[0].y - M1)};
                *(LAS f32x2*)(vw + t0) = (f32x2){__expf(gv[1].x - Ml), __expf(gv[1].y - Ml)};
                if (lane == 0) vsc[0] = __expf(mcar - Ml); }
            mcar = gl + Ml; }
#pragma unroll
        for (int it = 0; it < 8; ++it) { const int row0 = tid >> 5, c16 = tid & 31; *(LAS v4u*)(Kl + p7_koff(row0, c16) + 4096 * it) = kr[it]; }
#pragma unroll
        for (int it = 0; it < 2; ++it) { const int p = tid + 512 * it, sidx = p & 127, cg = p >> 7; const v4u v = vr[it];
            LAS bf16* d = (LAS bf16*)(VT + (8 * cg) * P7_VS) + sidx;
            d[0 * (P7_VS / 2)] = (bf16)(v.x & 0xffffu); d[1 * (P7_VS / 2)] = (bf16)(v.x >> 16); d[2 * (P7_VS / 2)] = (bf16)(v.y & 0xffffu); d[3 * (P7_VS / 2)] = (bf16)(v.y >> 16);
            d[4 * (P7_VS / 2)] = (bf16)(v.z & 0xffffu); d[5 * (P7_VS / 2)] = (bf16)(v.z >> 16); d[6 * (P7_VS / 2)] = (bf16)(v.w & 0xffffu); d[7 * (P7_VS / 2)] = (bf16)(v.w >> 16); }
        LDS_WAIT(); __syncthreads();
        f32x4 accS[8];
        { bf16x8 kfb[2][4];
          const int kbase = 256 * l15 + 16 * (q ^ fsw);
#define P7_KF(js_, ks_) (*(const LAS bf16x8*)(Kl + 256 * l15 + 16 * ((4 * ((ks_) & 3) + q) ^ fsw) + (((ks_) >> 2) << 15) + 4096 * (js_)))
          (void)kbase;
#pragma unroll
          for (int ks = 0; ks < 4; ++ks) kfb[0][ks] = P7_KF(0, ks);
#pragma unroll
          for (int g = 0; g < 16; ++g) { const int js = g >> 1, hf = g & 1;
              if (hf == 0) accS[js] = (f32x4){0.f, 0.f, 0.f, 0.f};
              if (js <= tb && !(ABL & 1)) {
                  if (g + 1 < 16 && ((g + 1) >> 1) <= tb) {
#pragma unroll
                      for (int ks = 0; ks < 4; ++ks) kfb[(g + 1) & 1][ks] = P7_KF((g + 1) >> 1, 4 * ((g + 1) & 1) + ks); }
                  __builtin_amdgcn_sched_barrier(0);
#pragma unroll
                  for (int ks = 0; ks < 4; ++ks) accS[js] = __builtin_amdgcn_mfma_f32_16x16x32_bf16(kfb[g & 1][ks], Qf[4 * hf + ks], accS[js], 0, 0, 0);
                  __builtin_amdgcn_sched_barrier(0); } }
#undef P7_KF
        }
        const int tl = 16 * tb + l15; const float Mt = vM[tl], iwt = viw[tl], flt = vfl[tl];
        unsigned pk[8][2];
#pragma unroll
        for (int js = 0; js < 8; ++js) { if constexpr (ABL & 16) { pk[js][0] = 0u; pk[js][1] = 0u; continue; } const f32x4 ev = *(const LAS f32x4*)(ve + 16 * js + 4 * q); const int s0 = 16 * js + 4 * q;
            const float p0 = (s0 + 0 <= tl) ? accS[js][0] * __expf(ev.x - Mt) : 0.f, p1 = (s0 + 1 <= tl) ? accS[js][1] * __expf(ev.y - Mt) : 0.f;
            const float p2 = (s0 + 2 <= tl) ? accS[js][2] * __expf(ev.z - Mt) : 0.f, p3 = (s0 + 3 <= tl) ? accS[js][3] * __expf(ev.w - Mt) : 0.f;
            pk[js][0] = pk2n(p0, p1); pk[js][1] = pk2n(p2, p3); }
        f32x4 acc3[5], acc4[5];
#pragma unroll
        for (int d = 0; d < 5; ++d) { acc3[d] = (f32x4){0.f, 0.f, 0.f, 0.f}; acc4[d] = (f32x4){0.f, 0.f, 0.f, 0.f}; }
#pragma unroll
        for (int a = 0; a < 4; ++a) if (2 * a <= tb && !(ABL & 1)) {
            const v4u pu = {pk[2 * a][0], pk[2 * a][1], pk[2 * a + 1][0], pk[2 * a + 1][1]}; const bf16x8 pf = __builtin_bit_cast(bf16x8, pu);
#pragma unroll
            for (int d = 0; d < 5; ++d) { const LAS unsigned char* vp = VT + (16 * d + l15) * P7_VS + 64 * a + 8 * q;
                const v2u lo = *(const LAS v2u*)vp, hi = *(const LAS v2u*)(vp + 32); const v4u vu = {lo.x, lo.y, hi.x, hi.y};
                acc3[d] = __builtin_amdgcn_mfma_f32_16x16x32_bf16(__builtin_bit_cast(bf16x8, vu), pf, acc3[d], 0, 0, 0); } }
        if constexpr (!(ABL & 2)) { bf16x8 cfb[2][4];
#define P7_CF(d_, ks_) (*(const LAS bf16x8*)(CT + (16 * (d_) + l15) * P7_KS + 64 * (ks_) + 16 * q))
#pragma unroll
          for (int ks = 0; ks < 4; ++ks) cfb[0][ks] = P7_CF(0, ks);
#pragma unroll
          for (int g = 0; g < 10; ++g) { const int d = g >> 1, hf = g & 1;
              if (g + 1 < 10) {
#pragma unroll
                  for (int ks = 0; ks < 4; ++ks) cfb[(g + 1) & 1][ks] = P7_CF((g + 1) >> 1, 4 * ((g + 1) & 1) + ks); }
              __builtin_amdgcn_sched_barrier(0);
#pragma unroll
              for (int ks = 0; ks < 4; ++ks) acc4[d] = __builtin_amdgcn_mfma_f32_16x16x32_bf16(cfb[g & 1][ks], Qf[4 * hf + ks], acc4[d], 0, 0, 0);
              __builtin_amdgcn_sched_barrier(0); }
#undef P7_CF
        }
        { const float den = __shfl(iwt * acc4[4][0] + acc3[4][0], l15);
          const float inv = 1.0f / fmaxf(fabsf(den), flt); float ss = 0.f;
          bf16* op = hs + (size_t)(m0 + tl) * D + h * DV + sl * 64 + 4 * q;
#pragma unroll
          for (int d = 0; d < 4; ++d) { const float o0 = (iwt * acc4[d][0] + acc3[d][0]) * inv, o1 = (iwt * acc4[d][1] + acc3[d][1]) * inv, o2 = (iwt * acc4[d][2] + acc3[d][2]) * inv, o3 = (iwt * acc4[d][3] + acc3[d][3]) * inv;
              ss += (o0 * o0 + o1 * o1) + (o2 * o2 + o3 * o3); v2u o; o.x = pk2n(o0, o1); o.y = pk2n(o2, o3); *(v2u*)(op + 16 * d) = o; }
          ss += __shfl_xor(ss, 16); ss += __shfl_xor(ss, 32);
          if (q == 0) hsstat[(size_t)(m0 + tl) * 64 + h * 8 + sl] = ss; }
        if (ch + 1 < NCH && !(ABL & 8)) P7_PREFETCH(ch + 1);
        { const float dec = vsc[0];
#pragma unroll
          for (int a = 0; a < 2; ++a)
#pragma unroll
              for (int d = 0; d < 5; ++d) accC[a][d] = accC[a][d] * dec; }
        if constexpr (!(ABL & 4))
#pragma unroll
        for (int a = 0; a < 4; ++a) {
            const f32x4 w0 = *(const LAS f32x4*)(vw + 32 * a + 4 * q), w1 = *(const LAS f32x4*)(vw + 32 * a + 16 + 4 * q);
            bf16x8 kt[2];
            { const int krb = 256 * l15 + 16 * ((4 * (w & 3) + q) ^ fsw) + ((w >> 2) << 15);
              const bf16x8 kr0 = *(const LAS bf16x8*)(Kl + krb + 8192 * a), kr1 = *(const LAS bf16x8*)(Kl + krb + 8192 * a + 4096);
#pragma unroll
              for (int kb = 0; kb < 2; ++kb) { const bf16x8 idf = __builtin_bit_cast(bf16x8, idw[kb]);
                  const f32x4 z4 = {0.f, 0.f, 0.f, 0.f};
                  const f32x4 d0 = __builtin_amdgcn_mfma_f32_16x16x32_bf16(kr0, idf, z4, 0, 0, 0), d1 = __builtin_amdgcn_mfma_f32_16x16x32_bf16(kr1, idf, z4, 0, 0, 0);
                  const v4u ku = {pk2n(d0[0] * w0.x, d0[1] * w0.y), pk2n(d0[2] * w0.z, d0[3] * w0.w), pk2n(d1[0] * w1.x, d1[1] * w1.y), pk2n(d1[2] * w1.z, d1[3] * w1.w)}; kt[kb] = __builtin_bit_cast(bf16x8, ku); } }
#pragma unroll
            for (int d = 0; d < 5; ++d) { const LAS unsigned char* vp = VT + (16 * d + l15) * P7_VS + 64 * a + 8 * q;
                const v2u lo = *(const LAS v2u*)vp, hi = *(const LAS v2u*)(vp + 32); const v4u vu = {lo.x, lo.y, hi.x, hi.y};
                const bf16x8 vf = __builtin_bit_cast(bf16x8, vu);
                accC[0][d] = __builtin_amdgcn_mfma_f32_16x16x32_bf16(kt[0], vf, accC[0][d], 0, 0, 0);
                accC[1][d] = __builtin_amdgcn_mfma_f32_16x16x32_bf16(kt[1], vf, accC[1][d], 0, 0, 0); } }
        LDS_WAIT(); __syncthreads();
#pragma unroll
        for (int kb = 0; kb < 2; ++kb)
#pragma unroll
            for (int d = 0; d < 5; ++d) { v2u o; o.x = pk2n(accC[kb][d][0], accC[kb][d][1]); o.y = pk2n(accC[kb][d][2], accC[kb][d][3]);
                *(LAS v2u*)(CT + (16 * d + l15) * P7_KS + 2 * (16 * (2 * w + kb) + 4 * q)) = o; }
    }
#undef P7_PREFETCH
    LDS_WAIT(); __syncthreads();
}

__device__ __forceinline__ void p8_headnorm(const bf16* hs, bf16* hso, const bf16* __restrict__ proj, const float* __restrict__ hsstat, const float* __restrict__ headg, int c, int wave, int lane) {
    const int pm = ((c & 7) << 3) | ((c >> 3) & 7), sub = c >> 6;
    for (int i = 0; i < 8; ++i) {
        const int m = pm * 256 + sub * 64 + wave * 8 + i;
#pragma unroll
        for (int hd = 0; hd < 8; ++hd) {
            const f32x4 s0 = *(const f32x4*)(hsstat + (size_t)m * 64 + hd * 8), s1 = *(const f32x4*)(hsstat + (size_t)m * 64 + hd * 8 + 4);
            const float rstd = 1.0f / sqrtf((((s0.x + s0.y) + (s0.z + s0.w)) + ((s1.x + s1.y) + (s1.z + s1.w))) * (1.f / DV) + EPS);
            const int col = hd * DV + 8 * lane;
            const v4u hv = *(const v4u*)(hs + (size_t)m * D + col), ov = *(const v4u*)(proj + (size_t)m * NP + 8192 + col);
            const f32x4 g0 = *(const f32x4*)(headg + col), g1 = *(const f32x4*)(headg + col + 4);
            const float hh[8] = {bf_lo(hv.x), bf_hi(hv.x), bf_lo(hv.y), bf_hi(hv.y), bf_lo(hv.z), bf_hi(hv.z), bf_lo(hv.w), bf_hi(hv.w)};
            const float oo[8] = {bf_lo(ov.x), bf_hi(ov.x), bf_lo(ov.y), bf_hi(ov.y), bf_lo(ov.z), bf_hi(ov.z), bf_lo(ov.w), bf_hi(ov.w)};
            const float gg[8] = {g0.x, g0.y, g0.z, g0.w, g1.x, g1.y, g1.z, g1.w};
            float r[8];
#pragma unroll
            for (int e = 0; e < 8; ++e) r[e] = hh[e] * rstd * gg[e] / (1.0f + __expf(-oo[e]));
            v4u o; o.x = pk2(r[0], r[1]); o.y = pk2(r[2], r[3]); o.z = pk2(r[4], r[5]); o.w = pk2(r[6], r[7]);
            *(v4u*)(hso + (size_t)m * D + col) = o;
        }
    }
}

__device__ __forceinline__ void p12_final(const bf16* __restrict__ hb, float* __restrict__ out, const float* __restrict__ hstat, const float* __restrict__ g, int c, int wave, int lane) {
    const int pm = ((c & 7) << 3) | ((c >> 3) & 7), sub = c >> 6;
    for (int i = 0; i < 8; ++i) {
        const int m = pm * 256 + sub * 64 + wave * 8 + i;
        const float sv = hstat[(size_t)m * 64 + lane];
        const float rstd = 1.0f / sqrtf(wave_sum(sv) * (1.f / D) + EPS);
        const v4u* rin = (const v4u*)(hb + (size_t)m * D) + lane; f32x4* row = (f32x4*)(out + (size_t)m * D) + 2 * lane; const f32x4* gr = (const f32x4*)g + 2 * lane;
#pragma unroll
        for (int j = 0; j < 8; ++j) { const v4u w = rin[64 * j]; const f32x4 g0 = gr[128 * j], g1 = gr[128 * j + 1];
            f32x4 v0 = {bf_lo(w.x) * rstd * g0.x, bf_hi(w.x) * rstd * g0.y, bf_lo(w.y) * rstd * g0.z, bf_hi(w.y) * rstd * g0.w};
            f32x4 v1 = {bf_lo(w.z) * rstd * g1.x, bf_hi(w.z) * rstd * g1.y, bf_lo(w.w) * rstd * g1.z, bf_hi(w.w) * rstd * g1.w};
            row[128 * j] = v0; row[128 * j + 1] = v1; }
    }
}

struct Args { const float* in[16]; float* out; unsigned char* ws; int ph_lo, ph_hi, li, pad; };
__global__ void __launch_bounds__(NWAVES * 64, 2) mk_fwd(Args args) {
    extern __shared__ __attribute__((aligned(16))) unsigned char lds_raw[];
    LAS unsigned char* lds = (LAS unsigned char*)lds_raw;
    volatile LAS unsigned* MISC = (volatile LAS unsigned*)(lds + MISC_OFF);
        const int G = gridDim.x, c = blockIdx.x;
    unsigned char* ws = args.ws;
    unsigned* ctl = (unsigned*)(ws + WS_CTL);
    const float* x = args.in[0]; const float* norm_mix = args.in[1]; const float* norm_ffn = args.in[2];
    const float* gm_w_in = args.in[3]; const float* gm_ln_g = args.in[4]; const float* gm_ln_b = args.in[5]; const float* gm_w_s = args.in[6]; const float* gm_b_s = args.in[7];
    const float* gm_w_out = args.in[8]; const float* ml_w_in = args.in[9]; const float* ml_b_gate = args.in[10]; const float* ml_head_g = args.in[11]; const float* ml_w_out = args.in[12];
    const float* ffn_w_up = args.in[13]; const float* ffn_w_down = args.in[14]; const float* norm_final = args.in[15];
    float* out = args.out;
    f32x2* vstat = (f32x2*)(ws + WS_VSTAT); float* hstat = (float*)(ws + WS_HSTAT); float* hsstat = (float*)(ws + WS_HSSTAT); float* gates = (float*)(ws + WS_GATES);
    bf16* W1 = (bf16*)(ws + WS_W1); bf16* W2 = (bf16*)(ws + WS_W2); bf16* WUP0 = (bf16*)(ws + WS_WUP0); bf16* WDN0 = (bf16*)(ws + WS_WDN0);
    bf16* WML = (bf16*)(ws + WS_WML); bf16* WMO = (bf16*)(ws + WS_WMO); bf16* WUP1 = (bf16*)(ws + WS_WUP1); bf16* WDN1 = (bf16*)(ws + WS_WDN1);
    bf16* HB = (bf16*)(ws + WS_HB); bf16* XB = (bf16*)(ws + WS_XB); bf16* Z = (bf16*)(ws + WS_Z); bf16* GATED = (bf16*)(ws + WS_GATED);
    bf16* A = (bf16*)(ws + WS_A); bf16* PROJ = (bf16*)(ws + WS_PROJ); bf16* HS = (bf16*)(ws + WS_HS);
    LAS float* rs = (LAS float*)(lds + RS_OFF);

    if (threadIdx.x < 64) MISC[threadIdx.x] = 0u;
    __syncthreads();
    XcdBarrier bar = xcd_barrier_post(ctl + CW_BAR + args.li * XCD_BAR_WORDS, MISC + 8);

    const int lo = args.ph_lo, hi = args.ph_hi;
#define IN(k) (lo <= (k) && (k) < hi)
#define TID() const int tid = pg8::fresh_tid(), lane = tid & 63, wave = __builtin_amdgcn_readfirstlane(tid >> 6); (void)lane; (void)wave;
#define SEAM(k) do { if (IN(k) && IN((k) + 1)) xcd_barrier(bar); } while (0)

    if (IN(0)) { TID();
        LAS float* scr = (LAS float*)(lds + wave * 16384);
        const int vcu = (c & 7) * (G >> 3) + (c >> 3);
        const int gw = vcu * NWAVES + wave, NGW = G * NWAVES;
        constexpr int I0 = (D / 64) * (NZ / 64), I1 = (D / 64) * (D / 64), I2 = (D / 64) * (FF / 64), I3 = (FF / 64) * (D / 64), I4 = (D / 64) * ((ML_IN + 63) / 64);
        constexpr int NITEMS = I0 + I1 + I2 + I3 + I4 + I1 + I2 + I3;
        for (int it = gw; it < NITEMS; it += NGW) {
            int r = it; WConv wc; int qcols = 0;
            if (r < I0) { wc = WConv{gm_w_in, nullptr, W1, D, NZ}; }
            else if ((r -= I0) < I1) { wc = WConv{gm_w_out, nullptr, W2, D, D}; }
            else if ((r -= I1) < I2) { wc = WConv{ffn_w_up, norm_ffn, WUP0, D, FF}; }
            else if ((r -= I2) < I3) { wc = WConv{ffn_w_down, nullptr, WDN0, FF, D}; }
            else if ((r -= I3) < I4) { wc = WConv{ml_w_in, norm_mix + D, WML, D, ML_IN}; qcols = 2048; }
            else if ((r -= I4) < I1) { wc = WConv{ml_w_out, nullptr, WMO, D, D}; }
            else if ((r -= I1) < I2) { wc = WConv{ffn_w_up + (size_t)D * FF, norm_ffn + D, WUP1, D, FF}; }
            else { r -= I2; wc = WConv{ffn_w_down + (size_t)FF * D, nullptr, WDN1, FF, D}; }
            p0_convert(wc, r, scr, lane, qcols);
        }
        for (int m = gw; m < M; m += NGW) p0_xrow(x + (size_t)m * D, norm_mix, XB + (size_t)m * D, lane);
    }
    SEAM(0);
    if (IN(1)) {
        pg8::Gemm g{XB, W1, M, NZ, D}; pg8::PanelOrder S; S.init(NZ, c);
        pg8::EpiGelu E{Z, NZ, (pg8::f32x2*)vstat};
        pg8::gemm_phase<pg8::EpiGelu, pg8::PanelOrder, true, true>(lds, g, S, E);
    }
    SEAM(1);
    if (IN(2)) { TID(); p2_spatial(lds, Z, vstat, gm_ln_g, gm_ln_b, gm_w_s, gm_b_s, GATED, c, tid); }
    SEAM(2);
    if (IN(3)) {
        pg8::Gemm g{GATED, W2, M, D, D}; pg8::PanelOrder S; S.init(D, c);
        pg8::EpiResid<true> E{x, HB, hstat};
        pg8::gemm_phase<pg8::EpiResid<true>, pg8::PanelOrder, true, true>(lds, g, S, E);
    }
    SEAM(3);
    if (IN(4)) { TID();
        pg8::PanelOrder S; S.init(FF, c);
        load_rstd_table(rs, hstat, S.pm, tid);
        pg8::Gemm g{HB, WUP0, M, FF, D};
        pg8::EpiScale<true> E{A, FF, rs};
        pg8::gemm_phase<pg8::EpiScale<true>, pg8::PanelOrder, true, true>(lds, g, S, E);
    }
    SEAM(4);
    if (IN(5)) {
        pg8::Gemm g{A, WDN0, M, D, FF}; pg8::PanelOrder S; S.init(D, c);
        pg8::EpiResid<false> E{nullptr, HB, hstat};
        pg8::gemm_phase<pg8::EpiResid<false>, pg8::PanelOrder, true, true>(lds, g, S, E);
    }
    SEAM(5);
    if (IN(6)) { TID();
        pg8::PanelOrder S; S.init(NP, c);
        load_rstd_table(rs, hstat, S.pm, tid);
        pg8::Gemm g{HB, WML, M, NP, D};
        pg8::EpiScale<false> E{PROJ, NP, rs};
        pg8::gemm_phase<pg8::EpiScale<false>, pg8::PanelOrder, true, true>(lds, g, S, E);
        p6_gates(HB, WML + (size_t)NP * D, rs, gates, c, wave, lane);
    }
    SEAM(6);
    if (IN(7)) { TID(); p7_mlstm(lds, PROJ, gates, ml_b_gate, HS, hsstat, (float*)(ws + WS_WUP0) + (size_t)c * (NCH * 384), c, tid); }
    SEAM(7);
    if (IN(8)) { TID(); p8_headnorm(HS, HS, PROJ, hsstat, ml_head_g, c, wave, lane); }
    SEAM(8);
    if (IN(9)) {
        pg8::Gemm g{HS, WMO, M, D, D}; pg8::PanelOrder S; S.init(D, c);
        pg8::EpiResid<false> E{nullptr, HB, hstat};
        pg8::gemm_phase<pg8::EpiResid<false>, pg8::PanelOrder, true, true>(lds, g, S, E);
    }
    SEAM(9);
    if (IN(10)) { TID();
        pg8::PanelOrder S; S.init(FF, c);
        load_rstd_table(rs, hstat, S.pm, tid);
        pg8::Gemm g{HB, WUP1, M, FF, D};
        pg8::EpiScale<true> E{A, FF, rs};
        pg8::gemm_phase<pg8::EpiScale<true>, pg8::PanelOrder, true, true>(lds, g, S, E);
    }
    SEAM(10);
    if (IN(11)) {
        pg8::Gemm g{A, WDN1, M, D, FF}; pg8::PanelOrder S; S.init(D, c);
        pg8::EpiResid<false> E{nullptr, HB, hstat};
        pg8::gemm_phase<pg8::EpiResid<false>, pg8::PanelOrder, true, true>(lds, g, S, E);
    }
    SEAM(11);
    if (IN(12)) { TID(); p12_final(HB, out, hstat, norm_final, c, wave, lane); }
#undef IN
#undef SEAM
}

extern "C" void kernel_launch(void* const* d_in, const int* in_sizes, int n_in, void* d_out, int out_size, void* d_ws, size_t ws_size, hipStream_t stream) {
    static int grid = 0;
    if (grid == 0) {
        if (n_in != 16 || in_sizes[0] != M * D || out_size != M * D || ws_size < WS_END) {
            fprintf(stderr, "kernel_launch: unexpected shapes: n_in %d in0 %d out %d ws %zu (need %zu)\n", n_in, n_in > 0 ? in_sizes[0] : -1, out_size, ws_size, (size_t)WS_END); grid = -1; return; }
        if (hipFuncSetAttribute((const void*)mk_fwd, hipFuncAttributeMaxDynamicSharedMemorySize, LDS_BYTES) != hipSuccess) { fprintf(stderr, "kernel_launch: hipFuncSetAttribute failed\n"); grid = -1; return; }
        int per_cu = 0;
        if (hipOccupancyMaxActiveBlocksPerMultiprocessor(&per_cu, (const void*)mk_fwd, NWAVES * 64, LDS_BYTES) != hipSuccess || per_cu < 1)
            fprintf(stderr, "kernel_launch: occupancy query reports %d workgroups per CU\n", per_cu);
        (void)hipGetLastError();
        grid = 256;
    }
    if (grid < 0) return;
    if (hipMemsetAsync((char*)d_ws + WS_CTL, 0, CTL_ZERO_BYTES, stream) != hipSuccess) { fprintf(stderr, "kernel_launch: memset failed\n"); return; }
    Args a{};
    for (int i = 0; i < 16; ++i) a.in[i] = (const float*)d_in[i];
    a.out = (float*)d_out; a.ws = (unsigned char*)d_ws;
#if MK_N_LAUNCHES == 1
    a.ph_lo = 0; a.ph_hi = N_PHASES; a.li = 0;
    hipLaunchKernelGGL(mk_fwd, dim3(grid), dim3(NWAVES * 64), LDS_BYTES, stream, a);
#else
    for (int p = 0; p < N_PHASES; ++p) { a.ph_lo = p; a.ph_hi = p + 1; a.li = 0; hipLaunchKernelGGL(mk_fwd, dim3(grid), dim3(NWAVES * 64), LDS_BYTES, stream, a); }
#endif
    const hipError_t le = hipPeekAtLastError();
    if (le != hipSuccess) fprintf(stderr, "kernel_launch: launch failed: %s\n", hipGetErrorName(le));
}
```

```cpp
#include <hip/hip_runtime.h>
#include <cstdio>
#include <cstdint>
namespace pg8 {
#define PG8_LAS __attribute__((address_space(3)))
typedef unsigned short bf16_t;
typedef short bf16x8 __attribute__((ext_vector_type(8)));
typedef float f32x4 __attribute__((ext_vector_type(4)));
typedef unsigned u32x4 __attribute__((ext_vector_type(4)));
constexpr int BM = 256, BK = 64, HALF = 128, HTB = HALF * BK * 2  , STAGE_BYTES = 8 * HTB, NXCD = 8, WGM = 8;

__host__ __device__ __forceinline__ int lds_byte(int r, int c) { const int st = (r >> 4) * 2 + (c >> 5), rr = r & 15, cc = c & 31, ob = rr * 64 + cc * 2; return st * 1024 + (ob ^ (((ob >> 9) & 1) << 5)); }
__host__ __device__ __forceinline__ void stage_rc(int b, int& R, int& C) { const int st = b / 1024, sb = b % 1024, swz = sb ^ (((sb >> 9) & 1) << 5); R = (st >> 1) * 16 + swz / 64; C = (st & 1) * 32 + (swz % 64) / 2; }
__host__ __device__ __forceinline__ int perm32(int rho) { const int n = rho >> 4, i = rho & 15; return 8 * (i >> 2) + 4 * n + (i & 3); }

struct Unit { int pm, pn; };
struct Gemm { const bf16_t* A; const bf16_t* Bt; int M, N, K; };

struct StaticOrder {
    int nM, nN, nwg, G, c;
    __host__ __device__ void init(int M, int N, int G_, int c_) { nM = M / BM; nN = N / BM; nwg = nM * nN; G = G_; c = c_; }
    __host__ __device__ bool next(int i, Unit& u) const {
        const long L = (long)i * G + c; if (L >= nwg) return false;
        int wgid = (int)L; { const int q = nwg / NXCD, r = nwg % NXCD, xcd = wgid % NXCD, off = wgid / NXCD; wgid = (xcd < r ? xcd * (q + 1) : r * (q + 1) + (xcd - r) * q) + off; }
        const int nig = WGM * nN, gid = wgid / nig, fm = gid * WGM, gsz = (nM - fm) < WGM ? (nM - fm) : WGM;
        u.pm = fm + ((wgid % nig) % gsz); u.pn = (wgid % nig) / gsz; return true;
    }
    __device__ __forceinline__ void a_ready(const Unit&) const {}
    __device__ __forceinline__ void done(const Unit&) const {}
};

struct PanelOrder {
    int pm, pn0, nr;
    __device__ __forceinline__ void init(int N, int c) { pm = ((c & 7) << 3) | ((c >> 3) & 7); pn0 = c >> 6; nr = (N / BM) / 4; }
    __device__ __forceinline__ bool next(int i, Unit& u) const { if (i >= nr) return false; u.pm = pm; u.pn = pn0 + 4 * i; return true; }
    __device__ __forceinline__ void a_ready(const Unit&) const {}
    __device__ __forceinline__ void done(const Unit&) const {}
};

typedef __bf16 bf16x2_native __attribute__((ext_vector_type(2)));
typedef float f32x2_native __attribute__((ext_vector_type(2)));
__device__ __forceinline__ unsigned cvt_pk_bf16_native(float lo, float hi) { const f32x2_native v = {lo, hi}; return __builtin_bit_cast(unsigned, __builtin_convertvector(v, bf16x2_native)); }
__device__ __forceinline__ unsigned cvt_pk_bf16(float lo, float hi) { unsigned r; asm volatile("v_cvt_pk_bf16_f32 %0, %1, %2" : "=v"(r) : "v"(lo), "v"(hi)); return r; }
__device__ __forceinline__ int fresh_tid() { int t = threadIdx.x; asm volatile("" : "+v"(t)); return t; }
#define PG8_FRESH_LANE() const int tz_ = fresh_tid(); const int wid_ = tz_ >> 6, lane_ = tz_ & 63; wr = wid_ >> 2; wc = wid_ & 3; fr = lane_ & 15; fq = lane_ >> 4;
typedef float f32x2 __attribute__((ext_vector_type(2)));
__device__ __forceinline__ f32x2 gelu_pk(f32x2 v) {
    const f32x2 av = __builtin_elementwise_abs(v), d = av * 0.2316418882f + 1.0f;
    f32x2 t; t.x = __builtin_amdgcn_rcpf(d.x); t.y = __builtin_amdgcn_rcpf(d.y);
    f32x2 q = t * 0.5307027145f + (-0.7265760135f); q = q * t + 0.7107068705f; q = q * t + (-0.142248368f); q = q * t + 0.127414796f; q = q * t;
    const f32x2 s = (v * v) * (-0.72134752044f);
    f32x2 e; e.x = __builtin_amdgcn_exp2f(s.x); e.y = __builtin_amdgcn_exp2f(s.y);
    const f32x2 m = v * (q * e), r = v - m;
    f32x2 o; o.x = v.x < 0.f ? m.x : r.x; o.y = v.y < 0.f ? m.y : r.y; return o;
}
__device__ __forceinline__ u32x4 pack8(const f32x4 v0, const f32x4 v1) { u32x4 w; w.x = cvt_pk_bf16(v0[0], v0[1]); w.y = cvt_pk_bf16(v0[2], v0[3]); w.z = cvt_pk_bf16(v1[0], v1[1]); w.w = cvt_pk_bf16(v1[2], v1[3]); return w; }

struct EpiGelu {
    static constexpr bool PERM = true, AFTER_DRAIN = false, HSC = false;
    bf16_t* O; int ldc; f32x2* vstat;
    __device__ __forceinline__ void operator()(const f32x4 (&acc)[2][2][4][2], const Unit& u, int wr, int wc, int fr, int fq) const {
        PG8_FRESH_LANE();
        const int row0 = u.pm * BM + wr * 64 + fr, col0 = u.pn * BM + wc * 32 + 8 * fq;
        const bool st = u.pn >= 16;
#pragma unroll
        for (int ai = 0; ai < 2; ++ai)
#pragma unroll
            for (int m = 0; m < 4; ++m) { const int r = row0 + ai * HALF + m * 16; bf16_t* rowp = O + (size_t)r * ldc + col0; float s1 = 0.f, s2 = 0.f;
#pragma unroll
                for (int bj = 0; bj < 2; ++bj) { f32x4 v0 = acc[ai][bj][m][0], v1 = acc[ai][bj][m][1];
                    const f32x2 a = gelu_pk((f32x2){v0[0], v0[1]}), b = gelu_pk((f32x2){v0[2], v0[3]}), c = gelu_pk((f32x2){v1[0], v1[1]}), d = gelu_pk((f32x2){v1[2], v1[3]});
                    v0 = (f32x4){a.x, a.y, b.x, b.y}; v1 = (f32x4){c.x, c.y, d.x, d.y};
                    s1 += ((v0[0] + v0[1]) + (v0[2] + v0[3])) + ((v1[0] + v1[1]) + (v1[2] + v1[3]));
                    s2 += ((v0[0] * v0[0] + v0[1] * v0[1]) + (v0[2] * v0[2] + v0[3] * v0[3])) + ((v1[0] * v1[0] + v1[1] * v1[1]) + (v1[2] * v1[2] + v1[3] * v1[3]));
                    *(u32x4*)(rowp + bj * HALF) = pack8(v0, v1); }
                s1 += __shfl_xor(s1, 16); s1 += __shfl_xor(s1, 32); s2 += __shfl_xor(s2, 16); s2 += __shfl_xor(s2, 32);
                if (st && fq == 0) vstat[((size_t)r * 16 + (u.pn - 16)) * 4 + wc] = (f32x2){s1, s2}; }
    }
};
template <bool XF32> struct EpiResid {
    static constexpr bool PERM = true, AFTER_DRAIN = false, HSC = false;
    const float* xres; bf16_t* hb; float* hstat;
    __device__ __forceinline__ void operator()(const f32x4 (&acc)[2][2][4][2], const Unit& u, int wr, int wc, int fr, int fq) const {
        PG8_FRESH_LANE();
        const int row0 = u.pm * BM + wr * 64 + fr, col0 = u.pn * BM + wc * 32 + 8 * fq;
#pragma unroll
        for (int g = 0; g < 8; ++g) { const int ai = g >> 2, m = g & 3;
            const int r = row0 + ai * HALF + m * 16; const size_t off = (size_t)r * 4096 + col0; float s2 = 0.f;
            f32x4 r0[2], r1[2];
#pragma unroll
            for (int bj = 0; bj < 2; ++bj) {
                if (XF32) { r0[bj] = *(const f32x4*)(xres + off + bj * HALF); r1[bj] = *(const f32x4*)(xres + off + bj * HALF + 4); }
                else { const u32x4 w = *(const u32x4*)(hb + off + bj * HALF);
                    r0[bj] = (f32x4){__builtin_bit_cast(float, w.x << 16), __builtin_bit_cast(float, w.x & 0xffff0000u), __builtin_bit_cast(float, w.y << 16), __builtin_bit_cast(float, w.y & 0xffff0000u)};
                    r1[bj] = (f32x4){__builtin_bit_cast(float, w.z << 16), __builtin_bit_cast(float, w.z & 0xffff0000u), __builtin_bit_cast(float, w.w << 16), __builtin_bit_cast(float, w.w & 0xffff0000u)}; } }
#pragma unroll
            for (int bj = 0; bj < 2; ++bj) { const f32x4 v0 = acc[ai][bj][m][0] + r0[bj], v1 = acc[ai][bj][m][1] + r1[bj];
                s2 += ((v0[0] * v0[0] + v0[1] * v0[1]) + (v0[2] * v0[2] + v0[3] * v0[3])) + ((v1[0] * v1[0] + v1[1] * v1[1]) + (v1[2] * v1[2] + v1[3] * v1[3]));
                *(u32x4*)(hb + off + bj * HALF) = pack8(v0, v1); }
            s2 += __shfl_xor(s2, 16); s2 += __shfl_xor(s2, 32);
            if (fq == 0) hstat[((size_t)r * 16 + u.pn) * 4 + wc] = s2;
            asm volatile("" ::: "memory"); }
    }
};
struct EpiResidH {
    static constexpr bool PERM = true, AFTER_DRAIN = false, HSC = true;
    bf16_t* hb; float* hstat; const PG8_LAS float* hsc;
    __device__ __forceinline__ void operator()(const f32x4 (&acc)[2][2][4][2], const Unit& u, int wr, int wc, int fr, int fq) const {
        PG8_FRESH_LANE();
        const int row0 = u.pm * BM + wr * 64 + fr, col0 = u.pn * BM + wc * 32 + 8 * fq;
#pragma unroll
        for (int g = 0; g < 8; ++g) { const int ai = g >> 2, m = g & 3;
            const int r = row0 + ai * HALF + m * 16; const float fs = hsc[(wr * 64 + fr + ai * HALF + m * 16) * 8]; const size_t off = (size_t)r * 4096 + col0; float s2 = 0.f;
            f32x4 r0[2], r1[2];
#pragma unroll
            for (int bj = 0; bj < 2; ++bj) {
                { const u32x4 w = *(const u32x4*)(hb + off + bj * HALF);
                    r0[bj] = (f32x4){__builtin_bit_cast(float, w.x << 16), __builtin_bit_cast(float, w.x & 0xffff0000u), __builtin_bit_cast(float, w.y << 16), __builtin_bit_cast(float, w.y & 0xffff0000u)};
                    r1[bj] = (f32x4){__builtin_bit_cast(float, w.z << 16), __builtin_bit_cast(float, w.z & 0xffff0000u), __builtin_bit_cast(float, w.w << 16), __builtin_bit_cast(float, w.w & 0xffff0000u)}; } }
#pragma unroll
            for (int bj = 0; bj < 2; ++bj) { const f32x4 v0 = acc[ai][bj][m][0] * fs + r0[bj], v1 = acc[ai][bj][m][1] * fs + r1[bj];
                s2 += ((v0[0] * v0[0] + v0[1] * v0[1]) + (v0[2] * v0[2] + v0[3] * v0[3])) + ((v1[0] * v1[0] + v1[1] * v1[1]) + (v1[2] * v1[2] + v1[3] * v1[3]));
                *(u32x4*)(hb + off + bj * HALF) = pack8(v0, v1); }
            s2 += __shfl_xor(s2, 16); s2 += __shfl_xor(s2, 32);
            if (fq == 0) hstat[((size_t)r * 16 + u.pn) * 4 + wc] = s2;
            asm volatile("" ::: "memory"); }
    }
};
template <bool SQ> struct EpiScale {
    static constexpr bool PERM = true, AFTER_DRAIN = false, HSC = false;
    bf16_t* O; int ldc; const PG8_LAS float* rs;
    __device__ __forceinline__ void operator()(const f32x4 (&acc)[2][2][4][2], const Unit& u, int wr, int wc, int fr, int fq) const {
        PG8_FRESH_LANE();
        const int rl0 = wr * 64 + fr, col0 = u.pn * BM + wc * 32 + 8 * fq;
#pragma unroll
        for (int ai = 0; ai < 2; ++ai)
#pragma unroll
            for (int m = 0; m < 4; ++m) { const int rl = rl0 + ai * HALF + m * 16; const float sc = rs[rl]; bf16_t* rowp = O + (size_t)(u.pm * BM + rl) * ldc + col0;
#pragma unroll
                for (int bj = 0; bj < 2; ++bj) { f32x4 v0 = acc[ai][bj][m][0] * sc, v1 = acc[ai][bj][m][1] * sc;
                    if (SQ) {
#pragma unroll
                        for (int j = 0; j < 4; ++j) { const float a = fmaxf(v0[j], 0.f), b = fmaxf(v1[j], 0.f); v0[j] = a * a; v1[j] = b * b; } }
                    *(u32x4*)(rowp + bj * HALF) = pack8(v0, v1); } }
    }
};
template <class Epi, class Sched, bool ALIGN_EPI = false, bool SP2 = false>
__device__ __forceinline__ void gemm_phase(PG8_LAS unsigned char* lds, const Gemm g, const Sched& S, const Epi& E) {
    const int tid = threadIdx.x, wid = __builtin_amdgcn_readfirstlane(tid >> 6), lane = tid & 63, wr = wid >> 2, wc = wid & 3, fr = lane & 15, fq = lane >> 4;
    const int K = g.K, nt = K / BK;
    unsigned voffA[2], voffB[2];
#pragma unroll
    for (int i = 0; i < 2; ++i) { int R, C; stage_rc(tid * 16 + i * 8192, R, C); const int Rb = Epi::PERM ? ((R & ~31) + perm32(R & 31)) : R;
        voffA[i] = (unsigned)(R * K + C) * 2u; voffB[i] = (unsigned)(Rb * K + C) * 2u; }
    const size_t kstep = (size_t)(BK * 2);
    const size_t hstep = (size_t)HALF * K * 2;
    const size_t tstep = 2 * hstep;
    const unsigned ldsw = (unsigned)wid * 1024u;
    const int aoff = lds_byte(wr * 64 + fr, fq * 8), boff = lds_byte(wc * 32 + fr, fq * 8);
#define PG8_SA(b, h) (((b) * 2 + (h)) * HTB)
#define PG8_SB(b, h) ((4 + (b) * 2 + (h)) * HTB)
#define PG8_STAGE(bufoff, gbase, voff) do { _Pragma("unroll") for (int _i = 0; _i < 2; ++_i) \
        __builtin_amdgcn_global_load_lds((const unsigned*)((const char*)(gbase) + (voff)[_i]), (PG8_LAS unsigned*)(lds + (bufoff) + ldsw + _i * 8192), 16, 0, 0); } while (0)
#define PG8_LDA(dst, b, h) do { _Pragma("unroll") for (int m = 0; m < 4; ++m) _Pragma("unroll") for (int k = 0; k < 2; ++k) dst[m][k] = *(const PG8_LAS bf16x8*)(lds + PG8_SA(b, h) + aoff + m * 2048 + k * 1024); } while (0)
#define PG8_LDB(dst, b, h) do { _Pragma("unroll") for (int n = 0; n < 2; ++n) _Pragma("unroll") for (int k = 0; k < 2; ++k) dst[n][k] = *(const PG8_LAS bf16x8*)(lds + PG8_SB(b, h) + boff + n * 2048 + k * 1024); } while (0)
#define PG8_MMA(ai, bj, At, Bt) do { __builtin_amdgcn_s_setprio(1); _Pragma("unroll") for (int m = 0; m < 4; ++m) _Pragma("unroll") for (int n = 0; n < 2; ++n) _Pragma("unroll") for (int k = 0; k < 2; ++k) \
        acc[ai][bj][m][n] = __builtin_amdgcn_mfma_f32_16x16x32_bf16(Bt[n][k], At[m][k], acc[ai][bj][m][n], 0, 0, 0); __builtin_amdgcn_s_setprio(0); } while (0)
#define PG8_WAIT_V(n) asm volatile("s_waitcnt vmcnt(" #n ")" ::: "memory")
#define PG8_WAIT_L(n) asm volatile("s_waitcnt lgkmcnt(" #n ")" ::: "memory")
#define PG8_BAR __builtin_amdgcn_s_barrier()
#define PG8_SCHED __builtin_amdgcn_sched_barrier(0)
    Unit cur, nxt; int ui = 0;
    if (!S.next(0, cur)) return;
    f32x4 acc[2][2][4][2];
#pragma unroll
    for (int a = 0; a < 2; ++a)
#pragma unroll
        for (int b = 0; b < 2; ++b)
#pragma unroll
            for (int m = 0; m < 4; ++m)
#pragma unroll
                for (int n = 0; n < 2; ++n) acc[a][b][m][n] = (f32x4){0.f, 0.f, 0.f, 0.f};
    bf16x8 At[4][2], B0[2][2], B1[2][2];
    const char* cA = (const char*)g.A + (size_t)cur.pm * tstep; const char* cB = (const char*)g.Bt + (size_t)cur.pn * tstep;
    S.a_ready(cur);
    if constexpr (SP2) {
        PG8_STAGE(PG8_SB(0, 0), cB, voffB); PG8_STAGE(PG8_SB(0, 1), cB + hstep, voffB); PG8_STAGE(PG8_SA(0, 0), cA, voffA); PG8_STAGE(PG8_SA(0, 1), cA + hstep, voffA);
        if (wr == 1) PG8_BAR;
        PG8_WAIT_V(2); PG8_BAR;
        PG8_STAGE(PG8_SB(1, 0), cB + kstep, voffB); PG8_STAGE(PG8_SA(1, 0), cA + kstep, voffA); PG8_STAGE(PG8_SB(1, 1), cB + hstep + kstep, voffB);
        PG8_WAIT_V(6); PG8_BAR;
    } else {
        PG8_STAGE(PG8_SB(0, 0), cB, voffB); PG8_STAGE(PG8_SA(0, 0), cA, voffA); PG8_STAGE(PG8_SB(0, 1), cB + hstep, voffB); PG8_STAGE(PG8_SA(0, 1), cA + hstep, voffA);
        if (wr == 1) PG8_BAR;
        PG8_WAIT_V(4); PG8_BAR;
        PG8_STAGE(PG8_SB(1, 0), cB + kstep, voffB); PG8_STAGE(PG8_SA(1, 0), cA + kstep, voffA); PG8_STAGE(PG8_SB(1, 1), cB + hstep + kstep, voffB);
        PG8_WAIT_V(6); PG8_BAR;
    }
    for (;;) {
        const bool has_next = S.next(ui + 1, nxt);
        const char* nA = has_next ? (const char*)g.A + (size_t)nxt.pm * tstep : cA; const char* nB = has_next ? (const char*)g.Bt + (size_t)nxt.pn * tstep : cB;
        for (int t = 0; t < nt; t += 2) {
            const bool last = (t == nt - 2);
            const char* a1 = cA + (size_t)(t + 1) * kstep;
            const char* a2 = last ? nA : cA + (size_t)(t + 2) * kstep; const char* b2 = last ? nB : cB + (size_t)(t + 2) * kstep;
            const char* a3 = a2 + kstep; const char* b3 = b2 + kstep;
            if (last && has_next) S.a_ready(nxt);
            if constexpr (Epi::HSC) { if (t > 0 && (t & 7) == 0) {
                const int hx = t >> 3;
#pragma unroll
                for (int ai = 0; ai < 2; ++ai)
#pragma unroll
                    for (int m = 0; m < 4; ++m) { const float sc = E.hsc[(wr * 64 + fr + ai * HALF + m * 16) * 8 + hx];
#pragma unroll
                        for (int bj = 0; bj < 2; ++bj) { acc[ai][bj][m][0] = acc[ai][bj][m][0] * sc; acc[ai][bj][m][1] = acc[ai][bj][m][1] * sc; } } } }
            if constexpr (SP2) {
            PG8_LDB(B0, 0, 0); PG8_LDB(B1, 0, 1); PG8_SCHED; PG8_LDA(At, 0, 0); PG8_STAGE(PG8_SA(1, 1), a1 + hstep, voffA);
            PG8_WAIT_V(8); PG8_WAIT_L(0); PG8_BAR; PG8_MMA(0, 0, At, B0); PG8_MMA(0, 1, At, B1); PG8_BAR; PG8_SCHED;
            PG8_LDA(At, 0, 1); PG8_STAGE(PG8_SB(0, 0), b2, voffB); PG8_STAGE(PG8_SB(0, 1), b2 + hstep, voffB); PG8_STAGE(PG8_SA(0, 0), a2, voffA);
            PG8_WAIT_V(8); PG8_WAIT_L(0); PG8_BAR; PG8_MMA(1, 0, At, B0); PG8_MMA(1, 1, At, B1); PG8_BAR; PG8_SCHED;
            PG8_LDB(B0, 1, 0); PG8_LDB(B1, 1, 1); PG8_SCHED; PG8_LDA(At, 1, 0); PG8_STAGE(PG8_SA(0, 1), a2 + hstep, voffA);
            PG8_WAIT_V(8); PG8_WAIT_L(0); PG8_BAR; PG8_MMA(0, 0, At, B0); PG8_MMA(0, 1, At, B1); PG8_BAR; PG8_SCHED;
            PG8_LDA(At, 1, 1); PG8_STAGE(PG8_SB(1, 0), b3, voffB); PG8_STAGE(PG8_SB(1, 1), b3 + hstep, voffB); PG8_STAGE(PG8_SA(1, 0), a3, voffA);
            PG8_WAIT_V(8); PG8_WAIT_L(0); PG8_BAR; PG8_MMA(1, 0, At, B0); PG8_MMA(1, 1, At, B1); PG8_BAR; PG8_SCHED;
            } else {
            PG8_LDB(B0, 0, 0); PG8_SCHED; PG8_LDA(At, 0, 0); PG8_STAGE(PG8_SA(1, 1), a1 + hstep, voffA);
            PG8_WAIT_L(8); PG8_BAR; PG8_WAIT_L(0); PG8_MMA(0, 0, At, B0); PG8_BAR; PG8_SCHED;
            PG8_LDB(B1, 0, 1); PG8_STAGE(PG8_SB(0, 0), b2, voffB);
            PG8_BAR; PG8_WAIT_L(0); PG8_MMA(0, 1, At, B1); PG8_BAR;
            PG8_LDA(At, 0, 1); PG8_STAGE(PG8_SA(0, 0), a2, voffA);
            PG8_BAR; PG8_WAIT_L(0); PG8_MMA(1, 0, At, B0); PG8_BAR; PG8_SCHED;
            PG8_STAGE(PG8_SB(0, 1), b2 + hstep, voffB);
            PG8_WAIT_V(6); PG8_BAR; PG8_MMA(1, 1, At, B1); PG8_BAR;
            PG8_LDB(B0, 1, 0); PG8_SCHED; PG8_LDA(At, 1, 0); PG8_STAGE(PG8_SA(0, 1), a2 + hstep, voffA);
            PG8_WAIT_L(8); PG8_BAR; PG8_WAIT_L(0); PG8_MMA(0, 0, At, B0); PG8_BAR; PG8_SCHED;
            PG8_LDB(B1, 1, 1); PG8_STAGE(PG8_SB(1, 0), b3, voffB);
            PG8_BAR; PG8_WAIT_L(0); PG8_MMA(0, 1, At, B1); PG8_BAR;
            PG8_LDA(At, 1, 1); PG8_STAGE(PG8_SA(1, 0), a3, voffA);
            PG8_BAR; PG8_WAIT_L(0); PG8_MMA(1, 0, At, B0); PG8_BAR; PG8_SCHED;
            PG8_STAGE(PG8_SB(1, 1), b3 + hstep, voffB);
            PG8_WAIT_V(6); PG8_BAR; PG8_MMA(1, 1, At, B1); PG8_BAR;
            }
        }
        if constexpr (ALIGN_EPI) { if (wr == 0) PG8_BAR; }
        if constexpr (!Epi::AFTER_DRAIN) { E(acc, cur, wr, wc, fr, fq); S.done(cur); }
        if (!has_next) break;
#pragma unroll
        for (int a = 0; a < 2; ++a)
#pragma unroll
            for (int b = 0; b < 2; ++b)
#pragma unroll
                for (int m = 0; m < 4; ++m)
#pragma unroll
                    for (int n = 0; n < 2; ++n) acc[a][b][m][n] = (f32x4){0.f, 0.f, 0.f, 0.f};
        cur = nxt; cA = nA; cB = nB; ++ui;
        if constexpr (ALIGN_EPI) { if (wr == 1) PG8_BAR; }
    }
    PG8_WAIT_V(0);
    if constexpr (!ALIGN_EPI) { if (wr == 0) PG8_BAR; }
    PG8_BAR;
    if constexpr (Epi::AFTER_DRAIN) { E.fused(acc, cur, wr, wc, fr, fq, lds, wid, lane); S.done(cur); }
#undef PG8_SA
#undef PG8_SB
#undef PG8_STAGE
#undef PG8_LDA
#undef PG8_LDB
#undef PG8_MMA
#undef PG8_WAIT_V
#undef PG8_WAIT_L
#undef PG8_BAR
#undef PG8_SCHED
}
}

constexpr int NWAVES = 8;
constexpr int BATCH = 4, SEQ = 4096, D = 4096, M = BATCH * SEQ, FF = 4 * D;
constexpr int NZ = 2 * D;
constexpr int HEADS = 8, DK = 256, DV = 512, CH = 128, NCH = SEQ / CH;
constexpr int NP = 2 * HEADS * DK + 2 * HEADS * DV;
constexpr int ML_IN = NP + 2 * HEADS;
constexpr float EPS = 1e-6f;
constexpr float GATE_CAP = 15.0f;
#ifndef MK_N_LAUNCHES
#define MK_N_LAUNCHES 1
#endif
constexpr int N_PHASES = 13;

constexpr size_t MiB = 1u << 20;
constexpr size_t WS_CTL = 0, CTL_ZERO_BYTES = 1 * MiB;
constexpr size_t WS_VSTAT = 1 * MiB;
constexpr size_t WS_HSTAT = 9 * MiB;
constexpr size_t WS_HSSTAT = 13 * MiB;
constexpr size_t WS_GATES = 17 * MiB;
constexpr size_t WS_W1 = 32 * MiB;
constexpr size_t WS_W2 = 96 * MiB;
constexpr size_t WS_WUP0 = 128 * MiB;
constexpr size_t WS_WDN0 = 256 * MiB;
constexpr size_t WS_WML = 384 * MiB;
constexpr size_t WS_WMO = 481 * MiB;
constexpr size_t WS_WUP1 = 513 * MiB;
constexpr size_t WS_WDN1 = 641 * MiB;
constexpr size_t WS_HB = 769 * MiB;
constexpr size_t WS_R = 897 * MiB;
constexpr size_t WS_XB = WS_R, WS_Z = WS_R + 128 * MiB, WS_GATED = WS_R + 384 * MiB;
constexpr size_t WS_A = WS_R;
constexpr size_t WS_PROJ = WS_R, WS_HS = WS_R + 384 * MiB;
constexpr size_t WS_END = WS_R + 512 * MiB;
static_assert(WS_WML + (size_t)ML_IN * D * 2 <= WS_WMO, "ws map");
constexpr int CW_BAR = 4096;

constexpr int RING_BYTES = 131072;
constexpr int RS_OFF = RING_BYTES;
constexpr int LDS_BYTES = 147456;
constexpr int MISC_OFF = LDS_BYTES - 256;

#define LAS __attribute__((address_space(3)))
typedef unsigned short bf16;
typedef unsigned v4u __attribute__((ext_vector_type(4)));
typedef unsigned v2u __attribute__((ext_vector_type(2)));
typedef float f32x4 __attribute__((ext_vector_type(4)));
typedef float f32x2 __attribute__((ext_vector_type(2)));
typedef short bf16x8 __attribute__((ext_vector_type(8)));
typedef short s16x4 __attribute__((ext_vector_type(4)));
#define LDS_WAIT() asm volatile("s_waitcnt lgkmcnt(0)" ::: "memory")
__device__ __forceinline__ unsigned f2bf(float f) { unsigned u = __builtin_bit_cast(unsigned, f); return (u + 0x7fffu + ((u >> 16) & 1u)) >> 16; }
__device__ __forceinline__ unsigned pk2(float lo, float hi) { return pg8::cvt_pk_bf16(lo, hi); }
__device__ __forceinline__ unsigned pk2n(float lo, float hi) { return pg8::cvt_pk_bf16_native(lo, hi); }
__device__ __forceinline__ float bf_lo(unsigned u) { return __builtin_bit_cast(float, u << 16); }
__device__ __forceinline__ float bf_hi(unsigned u) { return __builtin_bit_cast(float, u & 0xffff0000u); }
__device__ __forceinline__ float wave_sum(float v) {
#pragma unroll
    for (int o = 1; o < 64; o <<= 1) v += __shfl_xor(v, o);
    return v;
}
#define XB_TMO      128
#define XB_XCNT(j)  (256  + 64 * (j))
#define XB_XSUB(j)  (1280 + 64 * (j))
#define XB_XGEN(j)  (2304 + 64 * (j))
#define XB_TOP      3328
#define XB_TOPGEN   3392
#define XCD_BAR_WORDS 3456
#define XB_SPIN_CAP (1u << 18)

__device__ __forceinline__ unsigned xb_ld(unsigned* p)              { return __hip_atomic_load(p, __ATOMIC_RELAXED, __HIP_MEMORY_SCOPE_AGENT); }
__device__ __forceinline__ unsigned xb_add(unsigned* p, unsigned v) { return __hip_atomic_fetch_add(p, v, __ATOMIC_RELAXED, __HIP_MEMORY_SCOPE_AGENT); }
__device__ __forceinline__ unsigned xb_xcc_id() { return (unsigned)__builtin_amdgcn_s_getreg((3 << 11) | 20) & 0xFu; }
#define XB_SPIN(cond, bar) do { unsigned _sp = 0; while (cond) { __builtin_amdgcn_s_sleep(1); \
    if ((++_sp & 255u) == 0u) { if (xb_ld(&(bar)[XB_TMO])) break; if (_sp > XB_SPIN_CAP) { atomicAdd(&(bar)[XB_TMO], 1u); break; } } } } while (0)

struct XcdBarrier {
    unsigned* bar; unsigned x;
    volatile LAS unsigned* st;
};

__device__ __forceinline__ XcdBarrier xcd_barrier_post(unsigned* bar, volatile LAS unsigned* st) {
    XcdBarrier b; b.bar = bar; b.x = xb_xcc_id(); b.st = st;
    if (threadIdx.x == 0) (void)xb_add(&bar[XB_XCNT(b.x)], 1u);
    return b;
}
__device__ __forceinline__ void xcd_barrier_complete(unsigned* bar, unsigned x, unsigned& nloc, unsigned& nx) {
    const unsigned G = gridDim.x * gridDim.y * gridDim.z;
    unsigned sum, cnt, mine, sp = 0u;
    for (;;) {
        sum = 0u; cnt = 0u; mine = 0u;
#pragma unroll
        for (unsigned j = 0; j < 16; ++j) { const unsigned c = xb_ld(&bar[XB_XCNT(j)]); sum += c; cnt += (c > 0u) ? 1u : 0u; mine = (j == x) ? c : mine; }
        if (sum == G) break;
        __builtin_amdgcn_s_sleep(1);
        if ((++sp & 255u) == 0u) { if (xb_ld(&bar[XB_TMO])) break; if (sp > XB_SPIN_CAP) { atomicAdd(&bar[XB_TMO], 1u); break; } }
    }
    nloc = mine > 0u ? mine : 1u; nx = cnt > 0u ? cnt : 1u;
}

__device__ __forceinline__ void xcd_barrier(const XcdBarrier& b) {
    asm volatile("s_waitcnt vmcnt(0)" ::: "memory");
    __syncthreads();
    if (threadIdx.x == 0) {
        unsigned* bar = b.bar;
        __builtin_amdgcn_s_waitcnt(0);
        unsigned nloc = b.st[0], nx = b.st[1];
        if (nloc == 0u) { xcd_barrier_complete(bar, b.x, nloc, nx); b.st[0] = nloc; b.st[1] = nx; }
        const unsigned old = xb_add(&bar[XB_XSUB(b.x)], 1u);
        const unsigned gen = old / nloc;
        if (old + 1u == (gen + 1u) * nloc) {
            __builtin_amdgcn_fence(__ATOMIC_RELEASE, "agent");
            asm volatile("s_waitcnt vmcnt(0)" ::: "memory");
            const unsigned og = xb_add(&bar[XB_TOP], 1u);
            const unsigned tg = og / nx;
            if (og + 1u == (tg + 1u) * nx) xb_add(&bar[XB_TOPGEN], 1u);
            else XB_SPIN(xb_ld(&bar[XB_TOPGEN]) == tg, bar);
            __builtin_amdgcn_fence(__ATOMIC_ACQUIRE, "agent");
            xb_add(&bar[XB_XGEN(b.x)], 1u);
            asm volatile("s_waitcnt vmcnt(0)" ::: "memory");
        } else {
            XB_SPIN(xb_ld(&bar[XB_XGEN(b.x)]) == gen, bar);
            __builtin_amdgcn_fence(__ATOMIC_ACQUIRE, "agent");
            asm volatile("s_waitcnt vmcnt(0)" ::: "memory");
        }
    }
    __syncthreads();
}

__device__ __forceinline__ void p0_transpose_item(const float* __restrict__ W, int Nsrc, int K, int k0, int n0, int ncols, const float* __restrict__ gk, float cs,
                                                  bf16* __restrict__ WT, LAS float* scr, int lane) {
    const int nq = lane & 15, kh = lane >> 4;
    const bool okc = 4 * nq < ncols;
    f32x4 v[16];
    const float* src = W + (size_t)(k0 + kh) * Nsrc + n0 + 4 * nq;
#pragma unroll
    for (int i = 0; i < 16; ++i) v[i] = okc ? __builtin_nontemporal_load((const f32x4*)(src + (size_t)(4 * i) * Nsrc)) : (f32x4){0.f, 0.f, 0.f, 0.f};
    const int c = lane & 7;
    f32x4 g0 = {cs, cs, cs, cs}, g1 = {cs, cs, cs, cs};
    if (gk) { g0 = *(const f32x4*)(gk + k0 + 8 * c) * cs; g1 = *(const f32x4*)(gk + k0 + 8 * c + 4) * cs; }
#pragma unroll
    for (int i = 0; i < 16; ++i) { const int kk = 4 * i + kh; *(LAS f32x4*)(scr + kk * 64 + ((4 * nq) ^ (4 * ((kk >> 3) & 7)))) = v[i]; }
    LDS_WAIT(); asm volatile("" ::: "memory");
#pragma unroll
    for (int j = 0; j < 8; ++j) { const int n = (lane >> 3) + 8 * j; const LAS float* sp = scr + (8 * c) * 64 + (n ^ (4 * c));
        v4u o; o.x = pk2(sp[0 * 64] * g0.x, sp[1 * 64] * g0.y); o.y = pk2(sp[2 * 64] * g0.z, sp[3 * 64] * g0.w); o.z = pk2(sp[4 * 64] * g1.x, sp[5 * 64] * g1.y); o.w = pk2(sp[6 * 64] * g1.z, sp[7 * 64] * g1.w);
        if (n < ncols) *(v4u*)(WT + (size_t)(n0 + n) * K + k0 + 8 * c) = o; }
    LDS_WAIT(); asm volatile("" ::: "memory");
}
struct WConv { const float* W; const float* gk; bf16* WT; int K, Nsrc; };
__device__ __forceinline__ void p0_convert(const WConv& w, int item, LAS float* scr, int lane, int qcols) {
    const int nnb = (w.Nsrc + 63) / 64, kb = item / nnb, nb = item - kb * nnb, n0 = nb * 64;
    const int ncols = (w.Nsrc - n0) < 64 ? (w.Nsrc - n0) : 64;
    p0_transpose_item(w.W, w.Nsrc, w.K, kb * 64, n0, ncols, w.gk, n0 < qcols ? 0.0625f : 1.0f, w.WT, scr, lane);
}
__device__ __forceinline__ void p0_xrow(const float* __restrict__ xrow, const float* __restrict__ g, bf16* __restrict__ orow, int lane) {
    const f32x4* xr = (const f32x4*)xrow + lane; const f32x4* gr = (const f32x4*)g + lane;
    f32x4 v[16]; float s = 0.f;
#pragma unroll
    for (int j = 0; j < 16; ++j) { v[j] = __builtin_nontemporal_load(xr + 64 * j); s += (v[j].x * v[j].x + v[j].y * v[j].y) + (v[j].z * v[j].z + v[j].w * v[j].w); }
    const float rstd = 1.0f / sqrtf(wave_sum(s) * (1.f / D) + EPS);
    v2u* o8 = (v2u*)orow + lane;
#pragma unroll
    for (int j = 0; j < 16; ++j) { const f32x4 gg = gr[64 * j]; v2u o; o.x = pk2(v[j].x * rstd * gg.x, v[j].y * rstd * gg.y); o.y = pk2(v[j].z * rstd * gg.z, v[j].w * rstd * gg.w); o8[64 * j] = o; }
}

__device__ __forceinline__ void load_rstd_table(LAS float* rs, const float* __restrict__ hstat, int pm, int tid) {
    const int row = tid >> 1, half = tid & 1;
    const f32x4* p = (const f32x4*)(hstat + ((size_t)(pm * 256 + row) * 64 + half * 32));
    float s = 0.f;
#pragma unroll
    for (int j = 0; j < 8; ++j) { const f32x4 v = p[j]; s += (v.x + v.y) + (v.z + v.w); }
    s += __shfl_xor(s, 1);
    if (half == 0) rs[row] = 1.0f / sqrtf(s * (1.f / D) + EPS);
    LDS_WAIT(); __syncthreads();
}

__device__ __forceinline__ void load_head_table(LAS float* hsc, const float* __restrict__ hsstat, int pm, int tid) {
    if (tid < 256) { const f32x4* p = (const f32x4*)(hsstat + (size_t)(pm * 256 + tid) * 64);
        float rstd[8];
#pragma unroll
        for (int h = 0; h < 8; ++h) { const f32x4 s0 = p[2 * h], s1 = p[2 * h + 1]; rstd[h] = 1.0f / sqrtf((((s0.x + s0.y) + (s0.z + s0.w)) + ((s1.x + s1.y) + (s1.z + s1.w))) * (1.f / DV) + EPS); }
        f32x4 o0 = {rstd[7], rstd[0] / rstd[1], rstd[1] / rstd[2], rstd[2] / rstd[3]}, o1 = {rstd[3] / rstd[4], rstd[4] / rstd[5], rstd[5] / rstd[6], rstd[6] / rstd[7]};
        *(LAS f32x4*)(hsc + tid * 8) = o0; *(LAS f32x4*)(hsc + tid * 8 + 4) = o1; }
    LDS_WAIT(); __syncthreads();
}

__device__ __forceinline__ int img_off(int row, int ch) { return 256 * row + 16 * (ch ^ (((row & 3) << 2) | ((row >> 2) & 3))); }
__device__ __forceinline__ void p2_spatial(LAS unsigned char* lds, const bf16* __restrict__ z, const f32x2* __restrict__ vstat, const float* __restrict__ lng, const float* __restrict__ lnb,
                                           const float* __restrict__ ws_, const float* __restrict__ bs_, bf16* __restrict__ gated, int c, int tid0) {
    LAS unsigned char* Wimg = lds;
    LAS unsigned char* Vimg = lds + 32768;
    LAS float* mu = (LAS float*)(lds + 131072);
    LAS float* rsd = mu + 256;
    const int pm = ((c & 7) << 3) | ((c >> 3) & 7), sub = c >> 6;
    const int w = __builtin_amdgcn_readfirstlane(tid0 >> 6), jq = w & 3, th = w >> 2;
    __syncthreads();
    { const int row = tid0 >> 1, part = tid0 & 1;
      const f32x4* p = (const f32x4*)(vstat + ((size_t)(pm * 256 + row) * 64 + part * 32));
      float s1 = 0.f, s2 = 0.f;
#pragma unroll
      for (int j = 0; j < 16; ++j) { const f32x4 v = p[j]; s1 += v.x + v.z; s2 += v.y + v.w; }
      s1 += __shfl_xor(s1, 1); s2 += __shfl_xor(s2, 1);
      const float mean = s1 * (1.f / D); const float var = fmaxf(s2 * (1.f / D) - mean * mean, 0.f);
      if (part == 0) { mu[row] = mean; rsd[row] = 1.0f / sqrtf(var + EPS); } }
    v4u raw[8];
#define P2_LOADV(STEP) do { const int hi_ = (STEP) >> 2, cc_ = ((STEP) >> 1) & 1, hf_ = (STEP) & 1; const int tp = pg8::fresh_tid(); \
        const bf16* vp_ = z + (size_t)(pm * 256 + cc_ * 128 + (tp >> 5)) * NZ + D + (2 * sub + hi_) * 512 + hf_ * 256 + 8 * (tp & 31); \
        _Pragma("unroll") for (int it = 0; it < 8; ++it) raw[it] = *(const v4u*)(vp_ + (size_t)(16 * it) * NZ); } while (0)
    P2_LOADV(0);
    for (int step = 0; step < 8; ++step) {
        const int hi = step >> 2, cc = (step >> 1) & 1, hf = step & 1, hh = 2 * sub + hi;
        const int m0 = pm * 256 + cc * 128, j0 = hh * 512 + hf * 256;
        __syncthreads();
        if ((step & 3) == 0) { const int tid = pg8::fresh_tid();
#pragma unroll
          for (int it = 0; it < 4; ++it) { const int p = tid + 512 * it, t = p >> 4, ch = p & 15, s0 = 8 * ch;
              const f32x4 a = *(const f32x4*)(ws_ + ((size_t)hh * 128 + t) * 128 + s0), b = *(const f32x4*)(ws_ + ((size_t)hh * 128 + t) * 128 + s0 + 4);
              v4u o; o.x = pk2(s0 + 0 <= t ? a.x : 0.f, s0 + 1 <= t ? a.y : 0.f); o.y = pk2(s0 + 2 <= t ? a.z : 0.f, s0 + 3 <= t ? a.w : 0.f);
              o.z = pk2(s0 + 4 <= t ? b.x : 0.f, s0 + 5 <= t ? b.y : 0.f); o.w = pk2(s0 + 6 <= t ? b.z : 0.f, s0 + 7 <= t ? b.w : 0.f);
              *(LAS v4u*)(Wimg + img_off(t, ch)) = o; } }
        { const int tid = pg8::fresh_tid();
          const int cg = tid & 31; float g8[8], b8[8];
          { const f32x4 a = *(const f32x4*)(lng + j0 + 8 * cg), b = *(const f32x4*)(lng + j0 + 8 * cg + 4); g8[0] = a.x; g8[1] = a.y; g8[2] = a.z; g8[3] = a.w; g8[4] = b.x; g8[5] = b.y; g8[6] = b.z; g8[7] = b.w; }
          { const f32x4 a = *(const f32x4*)(lnb + j0 + 8 * cg), b = *(const f32x4*)(lnb + j0 + 8 * cg + 4); b8[0] = a.x; b8[1] = a.y; b8[2] = a.z; b8[3] = a.w; b8[4] = b.x; b8[5] = b.y; b8[6] = b.z; b8[7] = b.w; }
#pragma unroll
          for (int it = 0; it < 8; ++it) { const int sr = (tid >> 5) + 16 * it; const float mm = mu[cc * 128 + sr], rr = rsd[cc * 128 + sr];
              float f[8] = {bf_lo(raw[it].x), bf_hi(raw[it].x), bf_lo(raw[it].y), bf_hi(raw[it].y), bf_lo(raw[it].z), bf_hi(raw[it].z), bf_lo(raw[it].w), bf_hi(raw[it].w)};
#pragma unroll
              for (int e = 0; e < 8; ++e) f[e] = (f[e] - mm) * rr * g8[e] + b8[e];
              v4u o; o.x = pk2(f[0], f[1]); o.y = pk2(f[2], f[3]); o.z = pk2(f[4], f[5]); o.w = pk2(f[6], f[7]);
              *(LAS v4u*)(Vimg + ((cg >> 4) << 15) + img_off(sr, cg & 15)) = o; } }
        LDS_WAIT(); __syncthreads();
        if (step + 1 < 8) P2_LOADV(step + 1);
        const int tid = pg8::fresh_tid(), lane = tid & 63, l15 = lane & 15, q = lane >> 4;
        const int nks = 2 * th + 2;
        v2u uu[4][4]; float bsv[4];
#pragma unroll
        for (int tbq = 0; tbq < 4; ++tbq) { const int t = 16 * (4 * th + tbq) + l15; bsv[tbq] = bs_[hh * 128 + t];
#pragma unroll
            for (int jb = 0; jb < 4; ++jb) uu[jb][tbq] = *(const v2u*)(z + (size_t)(m0 + t) * NZ + j0 + 64 * jq + 16 * jb + 4 * q); }
#pragma unroll
        for (int jb = 0; jb < 4; ++jb) {
            const int jbl = 4 * jq + jb, cI = jbl & 7; const LAS unsigned char* vb = Vimg + ((jbl >> 3) << 15);
            bf16x8 Af[4];
#pragma unroll
            for (int ks = 0; ks < 4; ++ks) { if (ks < nks) {
                const int r0 = 32 * ks + 8 * q + (l15 >> 2), c8 = 2 * cI + ((l15 & 3) >> 1);
                const s16x4 t0 = __builtin_amdgcn_ds_read_tr16_b64_v4i16((LAS s16x4*)(vb + img_off(r0, c8) + 8 * (l15 & 1)));
                const s16x4 t1 = __builtin_amdgcn_ds_read_tr16_b64_v4i16((LAS s16x4*)(vb + img_off(r0 + 4, c8) + 8 * (l15 & 1)));
                Af[ks] = (bf16x8){t0[0], t0[1], t0[2], t0[3], t1[0], t1[1], t1[2], t1[3]}; } else Af[ks] = (bf16x8){0, 0, 0, 0, 0, 0, 0, 0}; }
#pragma unroll
            for (int tbq = 0; tbq < 4; ++tbq) {
                const int tb = 4 * th + tbq; f32x4 acc = {0.f, 0.f, 0.f, 0.f};
#pragma unroll
                for (int ks = 0; ks < 4; ++ks) if (2 * ks <= tb) { const bf16x8 bfr = *(const LAS bf16x8*)(Wimg + img_off(16 * tb + l15, 4 * ks + q));
                    acc = __builtin_amdgcn_mfma_f32_16x16x32_bf16(Af[ks], bfr, acc, 0, 0, 0); }
                const int t = 16 * tb + l15, j = j0 + 64 * jq + 16 * jb + 4 * q; const float bb = bsv[tbq]; const v2u u2 = uu[jb][tbq];
                v2u o; o.x = pk2n(bf_lo(u2.x) * (acc[0] + bb), bf_hi(u2.x) * (acc[1] + bb)); o.y = pk2n(bf_lo(u2.y) * (acc[2] + bb), bf_hi(u2.y) * (acc[3] + bb));
                *(v2u*)(gated + (size_t)(m0 + t) * D + j) = o;
            }
        }
    }
#undef P2_LOADV
}

__device__ __forceinline__ void p6_gates(const bf16* __restrict__ hb, const bf16* __restrict__ wg, const LAS float* rs, float* __restrict__ gates, int c, int wave, int lane) {
    if (wave >= 4) return;
    const int pm = ((c & 7) << 3) | ((c >> 3) & 7), sub = c >> 6;
    const int rl0 = 64 * sub + 16 * wave, l15 = lane & 15, q = lane >> 4;
    const bf16* ap = hb + (size_t)(pm * 256 + rl0 + l15) * D + 8 * q;
    const bf16* bp = wg + (size_t)l15 * D + 8 * q;
    f32x4 acc0 = {0.f, 0.f, 0.f, 0.f}, acc1 = {0.f, 0.f, 0.f, 0.f};
#pragma unroll 4
    for (int ks = 0; ks < D / 32; ks += 2) {
        const bf16x8 a0 = *(const bf16x8*)(ap + 32 * ks), b0 = *(const bf16x8*)(bp + 32 * ks);
        const bf16x8 a1 = *(const bf16x8*)(ap + 32 * ks + 32), b1 = *(const bf16x8*)(bp + 32 * ks + 32);
        acc0 = __builtin_amdgcn_mfma_f32_16x16x32_bf16(a0, b0, acc0, 0, 0, 0);
        acc1 = __builtin_amdgcn_mfma_f32_16x16x32_bf16(a1, b1, acc1, 0, 0, 0);
    }
#pragma unroll
    for (int r = 0; r < 4; ++r) { const int rl = rl0 + 4 * q + r; gates[(size_t)(pm * 256 + rl) * 16 + l15] = (acc0[r] + acc1[r]) * rs[rl]; }
}

constexpr int P7_KS = 528, P7_VS = 272, P7_K_OFF = 0, P7_VT_OFF = 65536, P7_CT_OFF = P7_VT_OFF + 80 * P7_VS, P7_VEC_OFF = P7_CT_OFF + 80 * P7_KS;
__device__ __forceinline__ int p7_koff(int row, int dk8  ) { const int ch = dk8 & 15; return ((dk8 >> 4) << 15) + 256 * row + 16 * (ch ^ (((row & 3) << 2) | ((row >> 2) & 3))); }
static_assert(P7_VEC_OFF + 4096 <= MISC_OFF && P7_VT_OFF % 16 == 0 && P7_CT_OFF % 16 == 0 && P7_VEC_OFF % 16 == 0, "P7 LDS map");
template <int ABL = 0> __device__ __forceinline__ void p7_mlstm(LAS unsigned char* lds, const bf16* __restrict__ proj, const float* __restrict__ gates, const float* __restrict__ bgate,
                                         bf16* __restrict__ hs, float* __restrict__ hsstat, float* __restrict__ gsc  , int c, int tid0) {
    const int w = __builtin_amdgcn_readfirstlane(tid0 >> 6);
    const int tb = w < 4 ? w : 11 - w;
    const int xcd = c & 7, y = c >> 3, bh = 8 * (y >> 3) + xcd, sl = y & 7, b = bh >> 3, h = bh & 7;
    LAS unsigned char* Kl = lds + P7_K_OFF; LAS unsigned char* VT = lds + P7_VT_OFF; LAS unsigned char* CT = lds + P7_CT_OFF;
    LAS float* ve = (LAS float*)(lds + P7_VEC_OFF);
    LAS float* vM = ve + 128, *viw = ve + 256, *vfl = ve + 384, *vw = ve + 512, *vsc = ve + 640;
    __syncthreads();
    for (int i = tid0; i < 80 * P7_KS / 4; i += 512) ((LAS unsigned*)CT)[i] = 0u;
    for (int i = tid0; i < 16 * P7_VS / 4; i += 512) ((LAS unsigned*)(VT + 64 * P7_VS))[i] = (i < P7_VS / 4) ? 0x3f803f80u : 0u;
    { const float bi = bgate[h], bfg = bgate[8 + h]; const int lane = tid0 & 63, t0 = 2 * lane;
      for (int ch = w; ch < NCH; ch += 8) { const int m0 = b * SEQ + ch * CH;
          float ip[2], lf[2];
#pragma unroll
          for (int k = 0; k < 2; ++k) { const float gi = gates[(size_t)(m0 + t0 + k) * 16 + h] + bi, gf = gates[(size_t)(m0 + t0 + k) * 16 + 8 + h] + bfg;
              ip[k] = GATE_CAP * tanhf(gi * (1.f / GATE_CAP)); const float fp = GATE_CAP * tanhf(gf * (1.f / GATE_CAP));
              lf[k] = fminf(fp, 0.f) - log1pf(expf(-fabsf(fp))); }
          const float pair = lf[0] + lf[1]; float inc = pair;
#pragma unroll
          for (int o = 1; o < 64; o <<= 1) { const float n = __shfl_up(inc, o); if (lane >= o) inc += n; }
          const float bc0 = (inc - pair) + lf[0], bc1 = inc;
          const float e0 = ip[0] - bc0, e1 = ip[1] - bc1;
          float im = fmaxf(e0, e1);
#pragma unroll
          for (int o = 1; o < 64; o <<= 1) { const float n = __shfl_up(im, o); if (lane >= o) im = fmaxf(im, n); }
          float ex = __shfl_up(im, 1); if (lane == 0) ex = -3.0e38f;
          f32x2* g2 = (f32x2*)(gsc + ch * 384) + lane;
          g2[0] = (f32x2){bc0, bc1}; g2[64] = (f32x2){e0, e1}; g2[128] = (f32x2){fmaxf(ex, e0), im}; } }
    f32x4 accC[2][5];
#pragma unroll
    for (int a = 0; a < 2; ++a)
#pragma unroll
        for (int d = 0; d < 5; ++d) accC[a][d] = (f32x4){0.f, 0.f, 0.f, 0.f};
    float mcar = 0.f;
    v4u idw[2];
#pragma unroll
    for (int kb = 0; kb < 2; ++kb) { const int tgt = 16 * kb + (tid0 & 15) - 8 * ((tid0 & 63) >> 4);
        idw[kb].x = (tgt == 0 ? 0x3f80u : 0u) | (tgt == 1 ? 0x3f800000u : 0u); idw[kb].y = (tgt == 2 ? 0x3f80u : 0u) | (tgt == 3 ? 0x3f800000u : 0u);
        idw[kb].z = (tgt == 4 ? 0x3f80u : 0u) | (tgt == 5 ? 0x3f800000u : 0u); idw[kb].w = (tgt == 6 ? 0x3f80u : 0u) | (tgt == 7 ? 0x3f800000u : 0u); }
    asm volatile("s_waitcnt vmcnt(0)" ::: "memory"); __syncthreads();
    v4u kr[8], vr[2]; bf16x8 Qf[8]; f32x2 gv[3];
#define P7_PREFETCH(CHN) do { const int m0n = b * SEQ + (CHN) * CH; const int tidp = pg8::fresh_tid(), lp = tidp & 63; \
        _Pragma("unroll") for (int it = 0; it < 8; ++it) { const int p = tidp + 512 * it, row = p >> 5, c16 = p & 31; kr[it] = *(const v4u*)(proj + (size_t)(m0n + row) * NP + 2048 + h * DK + 8 * c16); } \
        _Pragma("unroll") for (int it = 0; it < 2; ++it) { const int p = tidp + 512 * it, sidx = p & 127, cg = p >> 7; vr[it] = *(const v4u*)(proj + (size_t)(m0n + sidx) * NP + 4096 + h * DV + sl * 64 + 8 * cg); } \
        { const bf16* qp = proj + (size_t)(m0n + 16 * tb + (lp & 15)) * NP + h * DK + 8 * (lp >> 4); _Pragma("unroll") for (int ks = 0; ks < 8; ++ks) Qf[ks] = *(const bf16x8*)(qp + 32 * ks); } \
        { const f32x2* g2 = (const f32x2*)(gsc + (CHN) * 384) + lp; gv[0] = g2[0]; gv[1] = g2[64]; gv[2] = g2[128]; } } while (0)
    P7_PREFETCH(0);
    for (int ch = 0; ch < NCH; ++ch) {
        const int m0 = b * SEQ + ch * CH;
        const int tid = pg8::fresh_tid(), lane = tid & 63, l15 = lane & 15, q = lane >> 4;
        const int fsw = ((l15 & 3) << 2) | ((l15 >> 2) & 3);
        {
            const int t0 = 2 * lane;
            const float M0 = fmaxf(mcar, gv[2].x), M1 = fmaxf(mcar, gv[2].y);
            const float Ml = __shfl(M1, 63), gl = __shfl(gv[0].y, 63);
            if (w == 0) {
                *(LAS f32x2*)(ve + t0) = gv[1]; *(LAS f32x2*)(vM + t0) = (f32x2){M0, M1};
                *(LAS f32x2*)(viw + t0) = (f32x2){__expf(mcar - M0), __expf(mcar - M1)};
                *(LAS f32x2*)(vfl + t0) = (f32x2){__expf(-gv[0].x - M0), __expf(-gv[0].y - M1)};
                *(LAS f32x2*)(vw + t0) = (f32x2){__expf(gv[1].x - Ml), __expf(gv[1].y - Ml)};
                if (lane == 0) vsc[0] = __expf(mcar - Ml); }
            mcar = gl + Ml; }
#pragma unroll
        for (int it = 0; it < 8; ++it) { const int row0 = tid >> 5, c16 = tid & 31; *(LAS v4u*)(Kl + p7_koff(row0, c16) + 4096 * it) = kr[it]; }
#pragma unroll
        for (int it = 0; it < 2; ++it) { const int p = tid + 512 * it, sidx = p & 127, cg = p >> 7; const v4u v = vr[it];
            LAS bf16* d = (LAS bf16*)(VT + (8 * cg) * P7_VS) + sidx;
            d[0 * (P7_VS / 2)] = (bf16)(v.x & 0xffffu); d[1 * (P7_VS / 2)] = (bf16)(v.x >> 16); d[2 * (P7_VS / 2)] = (bf16)(v.y & 0xffffu); d[3 * (P7_VS / 2)] = (bf16)(v.y >> 16);
            d[4 * (P7_VS / 2)] = (bf16)(v.z & 0xffffu); d[5 * (P7_VS / 2)] = (bf16)(v.z >> 16); d[6 * (P7_VS / 2)] = (bf16)(v.w & 0xffffu); d[7 * (P7_VS / 2)] = (bf16)(v.w >> 16); }
        LDS_WAIT(); __syncthreads();
        f32x4 accS[8];
        { bf16x8 kfb[2][4];
          const int kbase = 256 * l15 + 16 * (q ^ fsw);
#define P7_KF(js_, ks_) (*(const LAS bf16x8*)(Kl + 256 * l15 + 16 * ((4 * ((ks_) & 3) + q) ^ fsw) + (((ks_) >> 2) << 15) + 4096 * (js_)))
          (void)kbase;
#pragma unroll
          for (int ks = 0; ks < 4; ++ks) kfb[0][ks] = P7_KF(0, ks);
#pragma unroll
          for (int g = 0; g < 16; ++g) { const int js = g >> 1, hf = g & 1;
              if (hf == 0) accS[js] = (f32x4){0.f, 0.f, 0.f, 0.f};
              if (js <= tb && !(ABL & 1)) {
                  if (g + 1 < 16 && ((g + 1) >> 1) <= tb) {
#pragma unroll
                      for (int ks = 0; ks < 4; ++ks) kfb[(g + 1) & 1][ks] = P7_KF((g + 1) >> 1, 4 * ((g + 1) & 1) + ks); }
                  __builtin_amdgcn_sched_barrier(0);
#pragma unroll
                  for (int ks = 0; ks < 4; ++ks) accS[js] = __builtin_amdgcn_mfma_f32_16x16x32_bf16(kfb[g & 1][ks], Qf[4 * hf + ks], accS[js], 0, 0, 0);
                  __builtin_amdgcn_sched_barrier(0); } }
#undef P7_KF
        }
        const int tl = 16 * tb + l15; const float Mt = vM[tl], iwt = viw[tl], flt = vfl[tl];
        unsigned pk[8][2];
#pragma unroll
        for (int js = 0; js < 8; ++js) { if constexpr (ABL & 16) { pk[js][0] = 0u; pk[js][1] = 0u; continue; } const f32x4 ev = *(const LAS f32x4*)(ve + 16 * js + 4 * q); const int s0 = 16 * js + 4 * q;
            const float p0 = (s0 + 0 <= tl) ? accS[js][0] * __expf(ev.x - Mt) : 0.f, p1 = (s0 + 1 <= tl) ? accS[js][1] * __expf(ev.y - Mt) : 0.f;
            const float p2 = (s0 + 2 <= tl) ? accS[js][2] * __expf(ev.z - Mt) : 0.f, p3 = (s0 + 3 <= tl) ? accS[js][3] * __expf(ev.w - Mt) : 0.f;
            pk[js][0] = pk2n(p0, p1); pk[js][1] = pk2n(p2, p3); }
        v2u og[4];
        { const bf16* gp = proj + (size_t)(m0 + tl) * NP + 8192 + h * DV + sl * 64 + 4 * q;
#pragma unroll
          for (int d = 0; d < 4; ++d) og[d] = *(const v2u*)(gp + 16 * d); }
        f32x4 acc3[5], acc4[5];
#pragma unroll
        for (int d = 0; d < 5; ++d) { acc3[d] = (f32x4){0.f, 0.f, 0.f, 0.f}; acc4[d] = (f32x4){0.f, 0.f, 0.f, 0.f}; }
#pragma unroll
        for (int a = 0; a < 4; ++a) if (2 * a <= tb && !(ABL & 1)) {
            const v4u pu = {pk[2 * a][0], pk[2 * a][1], pk[2 * a + 1][0], pk[2 * a + 1][1]}; const bf16x8 pf = __builtin_bit_cast(bf16x8, pu);
#pragma unroll
            for (int d = 0; d < 5; ++d) { const LAS unsigned char* vp = VT + (16 * d + l15) * P7_VS + 64 * a + 8 * q;
                const v2u lo = *(const LAS v2u*)vp, hi = *(const LAS v2u*)(vp + 32); const v4u vu = {lo.x, lo.y, hi.x, hi.y};
                acc3[d] = __builtin_amdgcn_mfma_f32_16x16x32_bf16(__builtin_bit_cast(bf16x8, vu), pf, acc3[d], 0, 0, 0); } }
        if constexpr (!(ABL & 2)) { bf16x8 cfb[2][4];
#define P7_CF(d_, ks_) (*(const LAS bf16x8*)(CT + (16 * (d_) + l15) * P7_KS + 64 * (ks_) + 16 * q))
#pragma unroll
          for (int ks = 0; ks < 4; ++ks) cfb[0][ks] = P7_CF(0, ks);
#pragma unroll
          for (int g = 0; g < 10; ++g) { const int d = g >> 1, hf = g & 1;
              if (g + 1 < 10) {
#pragma unroll
                  for (int ks = 0; ks < 4; ++ks) cfb[(g + 1) & 1][ks] = P7_CF((g + 1) >> 1, 4 * ((g + 1) & 1) + ks); }
              __builtin_amdgcn_sched_barrier(0);
#pragma unroll
              for (int ks = 0; ks < 4; ++ks) acc4[d] = __builtin_amdgcn_mfma_f32_16x16x32_bf16(cfb[g & 1][ks], Qf[4 * hf + ks], acc4[d], 0, 0, 0);
              __builtin_amdgcn_sched_barrier(0); }
#undef P7_CF
        }
        { const float den = __shfl(iwt * acc4[4][0] + acc3[4][0], l15);
          const float inv = 1.0f / fmaxf(fabsf(den), flt); float ss = 0.f;
          bf16* op = hs + (size_t)(m0 + tl) * D + h * DV + sl * 64 + 4 * q;
#pragma unroll
          for (int d = 0; d < 4; ++d) { const float o0 = (iwt * acc4[d][0] + acc3[d][0]) * inv, o1 = (iwt * acc4[d][1] + acc3[d][1]) * inv, o2 = (iwt * acc4[d][2] + acc3[d][2]) * inv, o3 = (iwt * acc4[d][3] + acc3[d][3]) * inv;
              ss += (o0 * o0 + o1 * o1) + (o2 * o2 + o3 * o3);
              const float s0 = 1.0f / (1.0f + __expf(-bf_lo(og[d].x))), s1 = 1.0f / (1.0f + __expf(-bf_hi(og[d].x))), s2 = 1.0f / (1.0f + __expf(-bf_lo(og[d].y))), s3 = 1.0f / (1.0f + __expf(-bf_hi(og[d].y)));
              v2u o; o.x = pk2n(o0 * s0, o1 * s1); o.y = pk2n(o2 * s2, o3 * s3); *(v2u*)(op + 16 * d) = o; }
          ss += __shfl_xor(ss, 16); ss += __shfl_xor(ss, 32);
          if (q == 0) hsstat[(size_t)(m0 + tl) * 64 + h * 8 + sl] = ss; }
        if (ch + 1 < NCH && !(ABL & 8)) P7_PREFETCH(ch + 1);
        { const float dec = vsc[0];
#pragma unroll
          for (int a = 0; a < 2; ++a)
#pragma unroll
              for (int d = 0; d < 5; ++d) accC[a][d] = accC[a][d] * dec; }
        if constexpr (!(ABL & 4))
#pragma unroll
        for (int a = 0; a < 4; ++a) {
            const f32x4 w0 = *(const LAS f32x4*)(vw + 32 * a + 4 * q), w1 = *(const LAS f32x4*)(vw + 32 * a + 16 + 4 * q);
            bf16x8 kt[2];
            { const int krb = 256 * l15 + 16 * ((4 * (w & 3) + q) ^ fsw) + ((w >> 2) << 15);
              const bf16x8 kr0 = *(const LAS bf16x8*)(Kl + krb + 8192 * a), kr1 = *(const LAS bf16x8*)(Kl + krb + 8192 * a + 4096);
#pragma unroll
              for (int kb = 0; kb < 2; ++kb) { const bf16x8 idf = __builtin_bit_cast(bf16x8, idw[kb]);
                  const f32x4 z4 = {0.f, 0.f, 0.f, 0.f};
                  const f32x4 d0 = __builtin_amdgcn_mfma_f32_16x16x32_bf16(kr0, idf, z4, 0, 0, 0), d1 = __builtin_amdgcn_mfma_f32_16x16x32_bf16(kr1, idf, z4, 0, 0, 0);
                  const v4u ku = {pk2n(d0[0] * w0.x, d0[1] * w0.y), pk2n(d0[2] * w0.z, d0[3] * w0.w), pk2n(d1[0] * w1.x, d1[1] * w1.y), pk2n(d1[2] * w1.z, d1[3] * w1.w)}; kt[kb] = __builtin_bit_cast(bf16x8, ku); } }
#pragma unroll
            for (int d = 0; d < 5; ++d) { const LAS unsigned char* vp = VT + (16 * d + l15) * P7_VS + 64 * a + 8 * q;
                const v2u lo = *(const LAS v2u*)vp, hi = *(const LAS v2u*)(vp + 32); const v4u vu = {lo.x, lo.y, hi.x, hi.y};
                const bf16x8 vf = __builtin_bit_cast(bf16x8, vu);
                accC[0][d] = __builtin_amdgcn_mfma_f32_16x16x32_bf16(kt[0], vf, accC[0][d], 0, 0, 0);
                accC[1][d] = __builtin_amdgcn_mfma_f32_16x16x32_bf16(kt[1], vf, accC[1][d], 0, 0, 0); } }
        LDS_WAIT(); __syncthreads();
#pragma unroll
        for (int kb = 0; kb < 2; ++kb)
#pragma unroll
            for (int d = 0; d < 5; ++d) { v2u o; o.x = pk2n(accC[kb][d][0], accC[kb][d][1]); o.y = pk2n(accC[kb][d][2], accC[kb][d][3]);
                *(LAS v2u*)(CT + (16 * d + l15) * P7_KS + 2 * (16 * (2 * w + kb) + 4 * q)) = o; }
    }
#undef P7_PREFETCH
    LDS_WAIT(); __syncthreads();
}

__device__ __forceinline__ void p8_headnorm(const bf16* hs, bf16* hso, const bf16* __restrict__ proj, const float* __restrict__ hsstat, const float* __restrict__ headg, int c, int wave, int lane) {
    const int pm = ((c & 7) << 3) | ((c >> 3) & 7), sub = c >> 6;
    for (int i = 0; i < 8; ++i) {
        const int m = pm * 256 + sub * 64 + wave * 8 + i;
#pragma unroll
        for (int hd = 0; hd < 8; ++hd) {
            const f32x4 s0 = *(const f32x4*)(hsstat + (size_t)m * 64 + hd * 8), s1 = *(const f32x4*)(hsstat + (size_t)m * 64 + hd * 8 + 4);
            const float rstd = 1.0f / sqrtf((((s0.x + s0.y) + (s0.z + s0.w)) + ((s1.x + s1.y) + (s1.z + s1.w))) * (1.f / DV) + EPS);
            const int col = hd * DV + 8 * lane;
            const v4u hv = *(const v4u*)(hs + (size_t)m * D + col), ov = *(const v4u*)(proj + (size_t)m * NP + 8192 + col);
            const f32x4 g0 = *(const f32x4*)(headg + col), g1 = *(const f32x4*)(headg + col + 4);
            const float hh[8] = {bf_lo(hv.x), bf_hi(hv.x), bf_lo(hv.y), bf_hi(hv.y), bf_lo(hv.z), bf_hi(hv.z), bf_lo(hv.w), bf_hi(hv.w)};
            const float oo[8] = {bf_lo(ov.x), bf_hi(ov.x), bf_lo(ov.y), bf_hi(ov.y), bf_lo(ov.z), bf_hi(ov.z), bf_lo(ov.w), bf_hi(ov.w)};
            const float gg[8] = {g0.x, g0.y, g0.z, g0.w, g1.x, g1.y, g1.z, g1.w};
            float r[8];
#pragma unroll
            for (int e = 0; e < 8; ++e) r[e] = hh[e] / (1.0f + __expf(-oo[e]));
            v4u o; o.x = pk2(r[0], r[1]); o.y = pk2(r[2], r[3]); o.z = pk2(r[4], r[5]); o.w = pk2(r[6], r[7]);
            *(v4u*)(hso + (size_t)m * D + col) = o;
        }
    }
}

__device__ __forceinline__ void p12_final(const bf16* __restrict__ hb, float* __restrict__ out, const float* __restrict__ hstat, const float* __restrict__ g, int c, int wave, int lane) {
    const int pm = ((c & 7) << 3) | ((c >> 3) & 7), sub = c >> 6;
    for (int i = 0; i < 8; ++i) {
        const int m = pm * 256 + sub * 64 + wave * 8 + i;
        const float sv = hstat[(size_t)m * 64 + lane];
        const float rstd = 1.0f / sqrtf(wave_sum(sv) * (1.f / D) + EPS);
        const v4u* rin = (const v4u*)(hb + (size_t)m * D) + lane; f32x4* row = (f32x4*)(out + (size_t)m * D) + 2 * lane; const f32x4* gr = (const f32x4*)g + 2 * lane;
#pragma unroll
        for (int j = 0; j < 8; ++j) { const v4u w = rin[64 * j]; const f32x4 g0 = gr[128 * j], g1 = gr[128 * j + 1];
            f32x4 v0 = {bf_lo(w.x) * rstd * g0.x, bf_hi(w.x) * rstd * g0.y, bf_lo(w.y) * rstd * g0.z, bf_hi(w.y) * rstd * g0.w};
            f32x4 v1 = {bf_lo(w.z) * rstd * g1.x, bf_hi(w.z) * rstd * g1.y, bf_lo(w.w) * rstd * g1.z, bf_hi(w.w) * rstd * g1.w};
            row[128 * j] = v0; row[128 * j + 1] = v1; }
    }
}

struct Args { const float* in[16]; float* out; unsigned char* ws; int ph_lo, ph_hi, li, pad; };
__global__ void __launch_bounds__(NWAVES * 64, 2) mk_fwd(Args args) {
    extern __shared__ __attribute__((aligned(16))) unsigned char lds_raw[];
    LAS unsigned char* lds = (LAS unsigned char*)lds_raw;
    volatile LAS unsigned* MISC = (volatile LAS unsigned*)(lds + MISC_OFF);
        const int G = gridDim.x, c = blockIdx.x;
    unsigned char* ws = args.ws;
    unsigned* ctl = (unsigned*)(ws + WS_CTL);
    const float* x = args.in[0]; const float* norm_mix = args.in[1]; const float* norm_ffn = args.in[2];
    const float* gm_w_in = args.in[3]; const float* gm_ln_g = args.in[4]; const float* gm_ln_b = args.in[5]; const float* gm_w_s = args.in[6]; const float* gm_b_s = args.in[7];
    const float* gm_w_out = args.in[8]; const float* ml_w_in = args.in[9]; const float* ml_b_gate = args.in[10]; const float* ml_head_g = args.in[11]; const float* ml_w_out = args.in[12];
    const float* ffn_w_up = args.in[13]; const float* ffn_w_down = args.in[14]; const float* norm_final = args.in[15];
    float* out = args.out;
    f32x2* vstat = (f32x2*)(ws + WS_VSTAT); float* hstat = (float*)(ws + WS_HSTAT); float* hsstat = (float*)(ws + WS_HSSTAT); float* gates = (float*)(ws + WS_GATES);
    bf16* W1 = (bf16*)(ws + WS_W1); bf16* W2 = (bf16*)(ws + WS_W2); bf16* WUP0 = (bf16*)(ws + WS_WUP0); bf16* WDN0 = (bf16*)(ws + WS_WDN0);
    bf16* WML = (bf16*)(ws + WS_WML); bf16* WMO = (bf16*)(ws + WS_WMO); bf16* WUP1 = (bf16*)(ws + WS_WUP1); bf16* WDN1 = (bf16*)(ws + WS_WDN1);
    bf16* HB = (bf16*)(ws + WS_HB); bf16* XB = (bf16*)(ws + WS_XB); bf16* Z = (bf16*)(ws + WS_Z); bf16* GATED = (bf16*)(ws + WS_GATED);
    bf16* A = (bf16*)(ws + WS_A); bf16* PROJ = (bf16*)(ws + WS_PROJ); bf16* HS = (bf16*)(ws + WS_HS);
    LAS float* rs = (LAS float*)(lds + RS_OFF);

    if (threadIdx.x < 64) MISC[threadIdx.x] = 0u;
    __syncthreads();
    XcdBarrier bar = xcd_barrier_post(ctl + CW_BAR + args.li * XCD_BAR_WORDS, MISC + 8);

    const int lo = args.ph_lo, hi = args.ph_hi;
#define IN(k) (lo <= (k) && (k) < hi)
#define TID() const int tid = pg8::fresh_tid(), lane = tid & 63, wave = __builtin_amdgcn_readfirstlane(tid >> 6); (void)lane; (void)wave;
#define SEAM(k) do { if (IN(k) && IN((k) + 1)) xcd_barrier(bar); } while (0)

    if (IN(0)) { TID();
        LAS float* scr = (LAS float*)(lds + wave * 16384);
        const int vcu = (c & 7) * (G >> 3) + (c >> 3);
        const int gw = vcu * NWAVES + wave, NGW = G * NWAVES;
        constexpr int I0 = (D / 64) * (NZ / 64), I1 = (D / 64) * (D / 64), I2 = (D / 64) * (FF / 64), I3 = (FF / 64) * (D / 64), I4 = (D / 64) * ((ML_IN + 63) / 64);
        constexpr int NITEMS = I0 + I1 + I2 + I3 + I4 + I1 + I2 + I3;
        for (int it = gw; it < NITEMS; it += NGW) {
            int r = it; WConv wc; int qcols = 0;
            if (r < I0) { wc = WConv{gm_w_in, nullptr, W1, D, NZ}; }
            else if ((r -= I0) < I1) { wc = WConv{gm_w_out, nullptr, W2, D, D}; }
            else if ((r -= I1) < I2) { wc = WConv{ffn_w_up, norm_ffn, WUP0, D, FF}; }
            else if ((r -= I2) < I3) { wc = WConv{ffn_w_down, nullptr, WDN0, FF, D}; }
            else if ((r -= I3) < I4) { wc = WConv{ml_w_in, norm_mix + D, WML, D, ML_IN}; qcols = 2048; }
            else if ((r -= I4) < I1) { wc = WConv{ml_w_out, ml_head_g, WMO, D, D}; }
            else if ((r -= I1) < I2) { wc = WConv{ffn_w_up + (size_t)D * FF, norm_ffn + D, WUP1, D, FF}; }
            else { r -= I2; wc = WConv{ffn_w_down + (size_t)FF * D, nullptr, WDN1, FF, D}; }
            p0_convert(wc, r, scr, lane, qcols);
        }
        for (int m = gw; m < M; m += NGW) p0_xrow(x + (size_t)m * D, norm_mix, XB + (size_t)m * D, lane);
    }
    SEAM(0);
    if (IN(1)) {
        pg8::Gemm g{XB, W1, M, NZ, D}; pg8::PanelOrder S; S.init(NZ, c);
        pg8::EpiGelu E{Z, NZ, (pg8::f32x2*)vstat};
        pg8::gemm_phase<pg8::EpiGelu, pg8::PanelOrder, true, true>(lds, g, S, E);
    }
    SEAM(1);
    if (IN(2)) { TID(); p2_spatial(lds, Z, vstat, gm_ln_g, gm_ln_b, gm_w_s, gm_b_s, GATED, c, tid); }
    SEAM(2);
    if (IN(3)) {
        pg8::Gemm g{GATED, W2, M, D, D}; pg8::PanelOrder S; S.init(D, c);
        pg8::EpiResid<true> E{x, HB, hstat};
        pg8::gemm_phase<pg8::EpiResid<true>, pg8::PanelOrder, true, true>(lds, g, S, E);
    }
    SEAM(3);
    if (IN(4)) { TID();
        pg8::PanelOrder S; S.init(FF, c);
        load_rstd_table(rs, hstat, S.pm, tid);
        pg8::Gemm g{HB, WUP0, M, FF, D};
        pg8::EpiScale<true> E{A, FF, rs};
        pg8::gemm_phase<pg8::EpiScale<true>, pg8::PanelOrder, true, true>(lds, g, S, E);
    }
    SEAM(4);
    if (IN(5)) {
        pg8::Gemm g{A, WDN0, M, D, FF}; pg8::PanelOrder S; S.init(D, c);
        pg8::EpiResid<false> E{nullptr, HB, hstat};
        pg8::gemm_phase<pg8::EpiResid<false>, pg8::PanelOrder, true, true>(lds, g, S, E);
    }
    SEAM(5);
    if (IN(6)) { TID();
        pg8::PanelOrder S; S.init(NP, c);
        load_rstd_table(rs, hstat, S.pm, tid);
        pg8::Gemm g{HB, WML, M, NP, D};
        pg8::EpiScale<false> E{PROJ, NP, rs};
        pg8::gemm_phase<pg8::EpiScale<false>, pg8::PanelOrder, true, true>(lds, g, S, E);
        p6_gates(HB, WML + (size_t)NP * D, rs, gates, c, wave, lane);
    }
    SEAM(6);
    if (IN(7)) { TID(); p7_mlstm(lds, PROJ, gates, ml_b_gate, HS, hsstat, (float*)(ws + WS_WUP0) + (size_t)c * (NCH * 384), c, tid); }
    do { if (IN(7) && IN(9)) xcd_barrier(bar); } while (0);
    if (IN(9)) {
        pg8::Gemm g{HS, WMO, M, D, D}; pg8::PanelOrder S; S.init(D, c);
        { TID(); load_head_table(rs, hsstat, S.pm, tid); }
        pg8::EpiResidH E{HB, hstat, rs};
        pg8::gemm_phase<pg8::EpiResidH, pg8::PanelOrder, true, true>(lds, g, S, E);
    }
    SEAM(9);
    if (IN(10)) { TID();
        pg8::PanelOrder S; S.init(FF, c);
        load_rstd_table(rs, hstat, S.pm, tid);
        pg8::Gemm g{HB, WUP1, M, FF, D};
        pg8::EpiScale<true> E{A, FF, rs};
        pg8::gemm_phase<pg8::EpiScale<true>, pg8::PanelOrder, true, true>(lds, g, S, E);
    }
    SEAM(10);
    if (IN(11)) {
        pg8::Gemm g{A, WDN1, M, D, FF}; pg8::PanelOrder S; S.init(D, c);
        pg8::EpiResid<false> E{nullptr, HB, hstat};
        pg8::gemm_phase<pg8::EpiResid<false>, pg8::PanelOrder, true, true>(lds, g, S, E);
    }
    SEAM(11);
    if (IN(12)) { TID(); p12_final(HB, out, hstat, norm_final, c, wave, lane); }
#undef IN
#undef SEAM
}

extern "C" void kernel_launch(void* const* d_in, const int* in_sizes, int n_in, void* d_out, int out_size, void* d_ws, size_t ws_size, hipStream_t stream) {
    static int grid = 0;
    if (grid == 0) {
        if (n_in != 16 || in_sizes[0] != M * D || out_size != M * D || ws_size < WS_END) {
            fprintf(stderr, "kernel_launch: unexpected shapes: n_in %d in0 %d out %d ws %zu (need %zu)\n", n_in, n_in > 0 ? in_sizes[0] : -1, out_size, ws_size, (size_t)WS_END); grid = -1; return; }
        if (hipFuncSetAttribute((const void*)mk_fwd, hipFuncAttributeMaxDynamicSharedMemorySize, LDS_BYTES) != hipSuccess) { fprintf(stderr, "kernel_launch: hipFuncSetAttribute failed\n"); grid = -1; return; }
        int per_cu = 0;
        if (hipOccupancyMaxActiveBlocksPerMultiprocessor(&per_cu, (const void*)mk_fwd, NWAVES * 64, LDS_BYTES) != hipSuccess || per_cu < 1)
            fprintf(stderr, "kernel_launch: occupancy query reports %d workgroups per CU\n", per_cu);
        (void)hipGetLastError();
        grid = 256;
    }
    if (grid < 0) return;
    if (hipMemsetAsync((char*)d_ws + WS_CTL, 0, CTL_ZERO_BYTES, stream) != hipSuccess) { fprintf(stderr, "kernel_launch: memset failed\n"); return; }
    Args a{};
    for (int i = 0; i < 16; ++i) a.in[i] = (const float*)d_in[i];
    a.out = (float*)d_out; a.ws = (unsigned char*)d_ws;
#if MK_N_LAUNCHES == 1
    a.ph_lo = 0; a.ph_hi = N_PHASES; a.li = 0;
    hipLaunchKernelGGL(mk_fwd, dim3(grid), dim3(NWAVES * 64), LDS_BYTES, stream, a);
#else
    for (int p = 0; p < N_PHASES; ++p) { a.ph_lo = p; a.ph_hi = p + 1; a.li = 0; hipLaunchKernelGGL(mk_fwd, dim3(grid), dim3(NWAVES * 64), LDS_BYTES, stream, a); }
#endif
    const hipError_t le = hipPeekAtLastError();
    if (le != hipSuccess) fprintf(stderr, "kernel_launch: launch failed: %s\n", hipGetErrorName(le));
}
```

```cpp
#include <hip/hip_runtime.h>
#include <cstdio>
#include <cstdint>
namespace pg8 {
#define PG8_LAS __attribute__((address_space(3)))
typedef unsigned short bf16_t;
typedef short bf16x8 __attribute__((ext_vector_type(8)));
typedef float f32x4 __attribute__((ext_vector_type(4)));
typedef unsigned u32x4 __attribute__((ext_vector_type(4)));
constexpr int BM = 256, BK = 64, HALF = 128, HTB = HALF * BK * 2  , STAGE_BYTES = 8 * HTB, NXCD = 8, WGM = 8;

__host__ __device__ __forceinline__ int lds_byte(int r, int c) { const int st = (r >> 4) * 2 + (c >> 5), rr = r & 15, cc = c & 31, ob = rr * 64 + cc * 2; return st * 1024 + (ob ^ (((ob >> 9) & 1) << 5)); }
__host__ __device__ __forceinline__ void stage_rc(int b, int& R, int& C) { const int st = b / 1024, sb = b % 1024, swz = sb ^ (((sb >> 9) & 1) << 5); R = (st >> 1) * 16 + swz / 64; C = (st & 1) * 32 + (swz % 64) / 2; }
__host__ __device__ __forceinline__ int perm32(int rho) { const int n = rho >> 4, i = rho & 15; return 8 * (i >> 2) + 4 * n + (i & 3); }

struct Unit { int pm, pn; };
struct Gemm { const bf16_t* A; const bf16_t* Bt; int M, N, K; };

struct StaticOrder {
    int nM, nN, nwg, G, c;
    __host__ __device__ void init(int M, int N, int G_, int c_) { nM = M / BM; nN = N / BM; nwg = nM * nN; G = G_; c = c_; }
    __host__ __device__ bool next(int i, Unit& u) const {
        const long L = (long)i * G + c; if (L >= nwg) return false;
        int wgid = (int)L; { const int q = nwg / NXCD, r = nwg % NXCD, xcd = wgid % NXCD, off = wgid / NXCD; wgid = (xcd < r ? xcd * (q + 1) : r * (q + 1) + (xcd - r) * q) + off; }
        const int nig = WGM * nN, gid = wgid / nig, fm = gid * WGM, gsz = (nM - fm) < WGM ? (nM - fm) : WGM;
        u.pm = fm + ((wgid % nig) % gsz); u.pn = (wgid % nig) / gsz; return true;
    }
    __device__ __forceinline__ void a_ready(const Unit&) const {}
    __device__ __forceinline__ void done(const Unit&) const {}
};

struct PanelOrder {
    int pm, pn0, nr;
    __device__ __forceinline__ void init(int N, int c) { pm = ((c & 7) << 3) | ((c >> 3) & 7); pn0 = c >> 6; nr = (N / BM) / 4; }
    __device__ __forceinline__ bool next(int i, Unit& u) const { if (i >= nr) return false; u.pm = pm; u.pn = pn0 + 4 * i; return true; }
    __device__ __forceinline__ void a_ready(const Unit&) const {}
    __device__ __forceinline__ void done(const Unit&) const {}
};

typedef __bf16 bf16x2_native __attribute__((ext_vector_type(2)));
typedef float f32x2_native __attribute__((ext_vector_type(2)));
__device__ __forceinline__ unsigned cvt_pk_bf16_native(float lo, float hi) { const f32x2_native v = {lo, hi}; return __builtin_bit_cast(unsigned, __builtin_convertvector(v, bf16x2_native)); }
__device__ __forceinline__ unsigned cvt_pk_bf16(float lo, float hi) { unsigned r; asm volatile("v_cvt_pk_bf16_f32 %0, %1, %2" : "=v"(r) : "v"(lo), "v"(hi)); return r; }
__device__ __forceinline__ int fresh_tid() { int t = threadIdx.x; asm volatile("" : "+v"(t)); return t; }
#define PG8_FRESH_LANE() const int tz_ = fresh_tid(); const int wid_ = tz_ >> 6, lane_ = tz_ & 63; wr = wid_ >> 2; wc = wid_ & 3; fr = lane_ & 15; fq = lane_ >> 4;
typedef float f32x2 __attribute__((ext_vector_type(2)));
__device__ __forceinline__ f32x2 gelu_pk(f32x2 v) {
    const f32x2 av = __builtin_elementwise_abs(v), d = av * 0.2316418882f + 1.0f;
    f32x2 t; t.x = __builtin_amdgcn_rcpf(d.x); t.y = __builtin_amdgcn_rcpf(d.y);
    f32x2 q = t * 0.5307027145f + (-0.7265760135f); q = q * t + 0.7107068705f; q = q * t + (-0.142248368f); q = q * t + 0.127414796f; q = q * t;
    const f32x2 s = (v * v) * (-0.72134752044f);
    f32x2 e; e.x = __builtin_amdgcn_exp2f(s.x); e.y = __builtin_amdgcn_exp2f(s.y);
    const f32x2 m = v * (q * e), r = v - m;
    f32x2 o; o.x = v.x < 0.f ? m.x : r.x; o.y = v.y < 0.f ? m.y : r.y; return o;
}
__device__ __forceinline__ u32x4 pack8(const f32x4 v0, const f32x4 v1) { u32x4 w; w.x = cvt_pk_bf16(v0[0], v0[1]); w.y = cvt_pk_bf16(v0[2], v0[3]); w.z = cvt_pk_bf16(v1[0], v1[1]); w.w = cvt_pk_bf16(v1[2], v1[3]); return w; }

struct EpiGelu {
    static constexpr bool PERM = true, AFTER_DRAIN = false, HSC = false;
    bf16_t* O; int ldc; f32x2* vstat;
    __device__ __forceinline__ void operator()(const f32x4 (&acc)[2][2][4][2], const Unit& u, int wr, int wc, int fr, int fq) const {
        PG8_FRESH_LANE();
        const int row0 = u.pm * BM + wr * 64 + fr, col0 = u.pn * BM + wc * 32 + 8 * fq;
        const bool st = u.pn >= 16;
#pragma unroll
        for (int ai = 0; ai < 2; ++ai)
#pragma unroll
            for (int m = 0; m < 4; ++m) { const int r = row0 + ai * HALF + m * 16; bf16_t* rowp = O + (size_t)r * ldc + col0; float s1 = 0.f, s2 = 0.f;
#pragma unroll
                for (int bj = 0; bj < 2; ++bj) { f32x4 v0 = acc[ai][bj][m][0], v1 = acc[ai][bj][m][1];
                    const f32x2 a = gelu_pk((f32x2){v0[0], v0[1]}), b = gelu_pk((f32x2){v0[2], v0[3]}), c = gelu_pk((f32x2){v1[0], v1[1]}), d = gelu_pk((f32x2){v1[2], v1[3]});
                    v0 = (f32x4){a.x, a.y, b.x, b.y}; v1 = (f32x4){c.x, c.y, d.x, d.y};
                    s1 += ((v0[0] + v0[1]) + (v0[2] + v0[3])) + ((v1[0] + v1[1]) + (v1[2] + v1[3]));
                    s2 += ((v0[0] * v0[0] + v0[1] * v0[1]) + (v0[2] * v0[2] + v0[3] * v0[3])) + ((v1[0] * v1[0] + v1[1] * v1[1]) + (v1[2] * v1[2] + v1[3] * v1[3]));
                    *(u32x4*)(rowp + bj * HALF) = pack8(v0, v1); }
                s1 += __shfl_xor(s1, 16); s1 += __shfl_xor(s1, 32); s2 += __shfl_xor(s2, 16); s2 += __shfl_xor(s2, 32);
                if (st && fq == 0) vstat[((size_t)r * 16 + (u.pn - 16)) * 4 + wc] = (f32x2){s1, s2}; }
    }
};
template <bool XF32> struct EpiResid {
    static constexpr bool PERM = true, AFTER_DRAIN = false, HSC = false;
    const float* xres; bf16_t* hb; float* hstat;
    __device__ __forceinline__ void operator()(const f32x4 (&acc)[2][2][4][2], const Unit& u, int wr, int wc, int fr, int fq) const {
        PG8_FRESH_LANE();
        const int row0 = u.pm * BM + wr * 64 + fr, col0 = u.pn * BM + wc * 32 + 8 * fq;
#pragma unroll
        for (int g = 0; g < 8; ++g) { const int ai = g >> 2, m = g & 3;
            const int r = row0 + ai * HALF + m * 16; const size_t off = (size_t)r * 4096 + col0; float s2 = 0.f;
            f32x4 r0[2], r1[2];
#pragma unroll
            for (int bj = 0; bj < 2; ++bj) {
                if (XF32) { r0[bj] = *(const f32x4*)(xres + off + bj * HALF); r1[bj] = *(const f32x4*)(xres + off + bj * HALF + 4); }
                else { const u32x4 w = *(const u32x4*)(hb + off + bj * HALF);
                    r0[bj] = (f32x4){__builtin_bit_cast(float, w.x << 16), __builtin_bit_cast(float, w.x & 0xffff0000u), __builtin_bit_cast(float, w.y << 16), __builtin_bit_cast(float, w.y & 0xffff0000u)};
                    r1[bj] = (f32x4){__builtin_bit_cast(float, w.z << 16), __builtin_bit_cast(float, w.z & 0xffff0000u), __builtin_bit_cast(float, w.w << 16), __builtin_bit_cast(float, w.w & 0xffff0000u)}; } }
#pragma unroll
            for (int bj = 0; bj < 2; ++bj) { const f32x4 v0 = acc[ai][bj][m][0] + r0[bj], v1 = acc[ai][bj][m][1] + r1[bj];
                s2 += ((v0[0] * v0[0] + v0[1] * v0[1]) + (v0[2] * v0[2] + v0[3] * v0[3])) + ((v1[0] * v1[0] + v1[1] * v1[1]) + (v1[2] * v1[2] + v1[3] * v1[3]));
                *(u32x4*)(hb + off + bj * HALF) = pack8(v0, v1); }
            s2 += __shfl_xor(s2, 16); s2 += __shfl_xor(s2, 32);
            if (fq == 0) hstat[((size_t)r * 16 + u.pn) * 4 + wc] = s2;
            asm volatile("" ::: "memory"); }
    }
};
struct EpiResidH {
    static constexpr bool PERM = true, AFTER_DRAIN = false, HSC = true;
    bf16_t* hb; float* hstat; const PG8_LAS float* hsc;
    __device__ __forceinline__ void operator()(const f32x4 (&acc)[2][2][4][2], const Unit& u, int wr, int wc, int fr, int fq) const {
        PG8_FRESH_LANE();
        const int row0 = u.pm * BM + wr * 64 + fr, col0 = u.pn * BM + wc * 32 + 8 * fq;
#pragma unroll
        for (int g = 0; g < 8; ++g) { const int ai = g >> 2, m = g & 3;
            const int r = row0 + ai * HALF + m * 16; const float fs = hsc[(wr * 64 + fr + ai * HALF + m * 16) * 8]; const size_t off = (size_t)r * 4096 + col0; float s2 = 0.f;
            f32x4 r0[2], r1[2];
#pragma unroll
            for (int bj = 0; bj < 2; ++bj) {
                { const u32x4 w = *(const u32x4*)(hb + off + bj * HALF);
                    r0[bj] = (f32x4){__builtin_bit_cast(float, w.x << 16), __builtin_bit_cast(float, w.x & 0xffff0000u), __builtin_bit_cast(float, w.y << 16), __builtin_bit_cast(float, w.y & 0xffff0000u)};
                    r1[bj] = (f32x4){__builtin_bit_cast(float, w.z << 16), __builtin_bit_cast(float, w.z & 0xffff0000u), __builtin_bit_cast(float, w.w << 16), __builtin_bit_cast(float, w.w & 0xffff0000u)}; } }
#pragma unroll
            for (int bj = 0; bj < 2; ++bj) { const f32x4 v0 = acc[ai][bj][m][0] * fs + r0[bj], v1 = acc[ai][bj][m][1] * fs + r1[bj];
                s2 += ((v0[0] * v0[0] + v0[1] * v0[1]) + (v0[2] * v0[2] + v0[3] * v0[3])) + ((v1[0] * v1[0] + v1[1] * v1[1]) + (v1[2] * v1[2] + v1[3] * v1[3]));
                *(u32x4*)(hb + off + bj * HALF) = pack8(v0, v1); }
            s2 += __shfl_xor(s2, 16); s2 += __shfl_xor(s2, 32);
            if (fq == 0) hstat[((size_t)r * 16 + u.pn) * 4 + wc] = s2;
            asm volatile("" ::: "memory"); }
    }
};
template <bool SQ> struct EpiScale {
    static constexpr bool PERM = true, AFTER_DRAIN = false, HSC = false;
    bf16_t* O; int ldc; const PG8_LAS float* rs;
    __device__ __forceinline__ void operator()(const f32x4 (&acc)[2][2][4][2], const Unit& u, int wr, int wc, int fr, int fq) const {
        PG8_FRESH_LANE();
        const int rl0 = wr * 64 + fr, col0 = u.pn * BM + wc * 32 + 8 * fq;
#pragma unroll
        for (int ai = 0; ai < 2; ++ai)
#pragma unroll
            for (int m = 0; m < 4; ++m) { const int rl = rl0 + ai * HALF + m * 16; const float sc = rs[rl]; bf16_t* rowp = O + (size_t)(u.pm * BM + rl) * ldc + col0;
#pragma unroll
                for (int bj = 0; bj < 2; ++bj) { f32x4 v0 = acc[ai][bj][m][0] * sc, v1 = acc[ai][bj][m][1] * sc;
                    if (SQ) {
#pragma unroll
                        for (int j = 0; j < 4; ++j) { const float a = fmaxf(v0[j], 0.f), b = fmaxf(v1[j], 0.f); v0[j] = a * a; v1[j] = b * b; } }
                    *(u32x4*)(rowp + bj * HALF) = pack8(v0, v1); } }
    }
};
template <class Epi, class Sched, bool ALIGN_EPI = false, bool SP2 = false>
__device__ __forceinline__ void gemm_phase(PG8_LAS unsigned char* lds, const Gemm g, const Sched& S, const Epi& E) {
    const int tid = threadIdx.x, wid = __builtin_amdgcn_readfirstlane(tid >> 6), lane = tid & 63, wr = wid >> 2, wc = wid & 3, fr = lane & 15, fq = lane >> 4;
    const int K = g.K, nt = K / BK;
    unsigned voffA[2], voffB[2];
#pragma unroll
    for (int i = 0; i < 2; ++i) { int R, C; stage_rc(tid * 16 + i * 8192, R, C); const int Rb = Epi::PERM ? ((R & ~31) + perm32(R & 31)) : R;
        voffA[i] = (unsigned)(R * K + C) * 2u; voffB[i] = (unsigned)(Rb * K + C) * 2u; }
    const size_t kstep = (size_t)(BK * 2);
    const size_t hstep = (size_t)HALF * K * 2;
    const size_t tstep = 2 * hstep;
    const unsigned ldsw = (unsigned)wid * 1024u;
    const int aoff = lds_byte(wr * 64 + fr, fq * 8), boff = lds_byte(wc * 32 + fr, fq * 8);
#define PG8_SA(b, h) (((b) * 2 + (h)) * HTB)
#define PG8_SB(b, h) ((4 + (b) * 2 + (h)) * HTB)
#define PG8_STAGE(bufoff, gbase, voff) do { _Pragma("unroll") for (int _i = 0; _i < 2; ++_i) \
        __builtin_amdgcn_global_load_lds((const unsigned*)((const char*)(gbase) + (voff)[_i]), (PG8_LAS unsigned*)(lds + (bufoff) + ldsw + _i * 8192), 16, 0, 0); } while (0)
#define PG8_LDA(dst, b, h) do { _Pragma("unroll") for (int m = 0; m < 4; ++m) _Pragma("unroll") for (int k = 0; k < 2; ++k) dst[m][k] = *(const PG8_LAS bf16x8*)(lds + PG8_SA(b, h) + aoff + m * 2048 + k * 1024); } while (0)
#define PG8_LDB(dst, b, h) do { _Pragma("unroll") for (int n = 0; n < 2; ++n) _Pragma("unroll") for (int k = 0; k < 2; ++k) dst[n][k] = *(const PG8_LAS bf16x8*)(lds + PG8_SB(b, h) + boff + n * 2048 + k * 1024); } while (0)
#define PG8_MMA(ai, bj, At, Bt) do { __builtin_amdgcn_s_setprio(1); _Pragma("unroll") for (int m = 0; m < 4; ++m) _Pragma("unroll") for (int n = 0; n < 2; ++n) _Pragma("unroll") for (int k = 0; k < 2; ++k) \
        acc[ai][bj][m][n] = __builtin_amdgcn_mfma_f32_16x16x32_bf16(Bt[n][k], At[m][k], acc[ai][bj][m][n], 0, 0, 0); __builtin_amdgcn_s_setprio(0); } while (0)
#define PG8_WAIT_V(n) asm volatile("s_waitcnt vmcnt(" #n ")" ::: "memory")
#define PG8_WAIT_L(n) asm volatile("s_waitcnt lgkmcnt(" #n ")" ::: "memory")
#define PG8_BAR __builtin_amdgcn_s_barrier()
#define PG8_SCHED __builtin_amdgcn_sched_barrier(0)
    Unit cur, nxt; int ui = 0;
    if (!S.next(0, cur)) return;
    f32x4 acc[2][2][4][2];
#pragma unroll
    for (int a = 0; a < 2; ++a)
#pragma unroll
        for (int b = 0; b < 2; ++b)
#pragma unroll
            for (int m = 0; m < 4; ++m)
#pragma unroll
                for (int n = 0; n < 2; ++n) acc[a][b][m][n] = (f32x4){0.f, 0.f, 0.f, 0.f};
    bf16x8 At[4][2], B0[2][2], B1[2][2];
    const char* cA = (const char*)g.A + (size_t)cur.pm * tstep; const char* cB = (const char*)g.Bt + (size_t)cur.pn * tstep;
    S.a_ready(cur);
    if constexpr (SP2) {
        PG8_STAGE(PG8_SB(0, 0), cB, voffB); PG8_STAGE(PG8_SB(0, 1), cB + hstep, voffB); PG8_STAGE(PG8_SA(0, 0), cA, voffA); PG8_STAGE(PG8_SA(0, 1), cA + hstep, voffA);
        if (wr == 1) PG8_BAR;
        PG8_WAIT_V(2); PG8_BAR;
        PG8_STAGE(PG8_SB(1, 0), cB + kstep, voffB); PG8_STAGE(PG8_SA(1, 0), cA + kstep, voffA); PG8_STAGE(PG8_SB(1, 1), cB + hstep + kstep, voffB);
        PG8_WAIT_V(6); PG8_BAR;
    } else {
        PG8_STAGE(PG8_SB(0, 0), cB, voffB); PG8_STAGE(PG8_SA(0, 0), cA, voffA); PG8_STAGE(PG8_SB(0, 1), cB + hstep, voffB); PG8_STAGE(PG8_SA(0, 1), cA + hstep, voffA);
        if (wr == 1) PG8_BAR;
        PG8_WAIT_V(4); PG8_BAR;
        PG8_STAGE(PG8_SB(1, 0), cB + kstep, voffB); PG8_STAGE(PG8_SA(1, 0), cA + kstep, voffA); PG8_STAGE(PG8_SB(1, 1), cB + hstep + kstep, voffB);
        PG8_WAIT_V(6); PG8_BAR;
    }
    for (;;) {
        const bool has_next = S.next(ui + 1, nxt);
        const char* nA = has_next ? (const char*)g.A + (size_t)nxt.pm * tstep : cA; const char* nB = has_next ? (const char*)g.Bt + (size_t)nxt.pn * tstep : cB;
        for (int t = 0; t < nt; t += 2) {
            const bool last = (t == nt - 2);
            const char* a1 = cA + (size_t)(t + 1) * kstep;
            const char* a2 = last ? nA : cA + (size_t)(t + 2) * kstep; const char* b2 = last ? nB : cB + (size_t)(t + 2) * kstep;
            const char* a3 = a2 + kstep; const char* b3 = b2 + kstep;
            if (last && has_next) S.a_ready(nxt);
            if constexpr (Epi::HSC) { if (t > 0 && (t & 7) == 0) {
                const int hx = t >> 3;
#pragma unroll
                for (int ai = 0; ai < 2; ++ai)
#pragma unroll
                    for (int m = 0; m < 4; ++m) { const float sc = E.hsc[(wr * 64 + fr + ai * HALF + m * 16) * 8 + hx];
#pragma unroll
                        for (int bj = 0; bj < 2; ++bj) { acc[ai][bj][m][0] = acc[ai][bj][m][0] * sc; acc[ai][bj][m][1] = acc[ai][bj][m][1] * sc; } } } }
            if constexpr (SP2) {
            PG8_LDB(B0, 0, 0); PG8_LDB(B1, 0, 1); PG8_SCHED; PG8_LDA(At, 0, 0); PG8_STAGE(PG8_SA(1, 1), a1 + hstep, voffA);
            PG8_WAIT_V(8); PG8_WAIT_L(0); PG8_BAR; PG8_MMA(0, 0, At, B0); PG8_MMA(0, 1, At, B1); PG8_BAR; PG8_SCHED;
            PG8_LDA(At, 0, 1); PG8_STAGE(PG8_SB(0, 0), b2, voffB); PG8_STAGE(PG8_SB(0, 1), b2 + hstep, voffB); PG8_STAGE(PG8_SA(0, 0), a2, voffA);
            PG8_WAIT_V(8); PG8_WAIT_L(0); PG8_BAR; PG8_MMA(1, 0, At, B0); PG8_MMA(1, 1, At, B1); PG8_BAR; PG8_SCHED;
            PG8_LDB(B0, 1, 0); PG8_LDB(B1, 1, 1); PG8_SCHED; PG8_LDA(At, 1, 0); PG8_STAGE(PG8_SA(0, 1), a2 + hstep, voffA);
            PG8_WAIT_V(8); PG8_WAIT_L(0); PG8_BAR; PG8_MMA(0, 0, At, B0); PG8_MMA(0, 1, At, B1); PG8_BAR; PG8_SCHED;
            PG8_LDA(At, 1, 1); PG8_STAGE(PG8_SB(1, 0), b3, voffB); PG8_STAGE(PG8_SB(1, 1), b3 + hstep, voffB); PG8_STAGE(PG8_SA(1, 0), a3, voffA);
            PG8_WAIT_V(8); PG8_WAIT_L(0); PG8_BAR; PG8_MMA(1, 0, At, B0); PG8_MMA(1, 1, At, B1); PG8_BAR; PG8_SCHED;
            } else {
            PG8_LDB(B0, 0, 0); PG8_SCHED; PG8_LDA(At, 0, 0); PG8_STAGE(PG8_SA(1, 1), a1 + hstep, voffA);
            PG8_WAIT_L(8); PG8_BAR; PG8_WAIT_L(0); PG8_MMA(0, 0, At, B0); PG8_BAR; PG8_SCHED;
            PG8_LDB(B1, 0, 1); PG8_STAGE(PG8_SB(0, 0), b2, voffB);
            PG8_BAR; PG8_WAIT_L(0); PG8_MMA(0, 1, At, B1); PG8_BAR;
            PG8_LDA(At, 0, 1); PG8_STAGE(PG8_SA(0, 0), a2, voffA);
            PG8_BAR; PG8_WAIT_L(0); PG8_MMA(1, 0, At, B0); PG8_BAR; PG8_SCHED;
            PG8_STAGE(PG8_SB(0, 1), b2 + hstep, voffB);
            PG8_WAIT_V(6); PG8_BAR; PG8_MMA(1, 1, At, B1); PG8_BAR;
            PG8_LDB(B0, 1, 0); PG8_SCHED; PG8_LDA(At, 1, 0); PG8_STAGE(PG8_SA(0, 1), a2 + hstep, voffA);
            PG8_WAIT_L(8); PG8_BAR; PG8_WAIT_L(0); PG8_MMA(0, 0, At, B0); PG8_BAR; PG8_SCHED;
            PG8_LDB(B1, 1, 1); PG8_STAGE(PG8_SB(1, 0), b3, voffB);
            PG8_BAR; PG8_WAIT_L(0); PG8_MMA(0, 1, At, B1); PG8_BAR;
            PG8_LDA(At, 1, 1); PG8_STAGE(PG8_SA(1, 0), a3, voffA);
            PG8_BAR; PG8_WAIT_L(0); PG8_MMA(1, 0, At, B0); PG8_BAR; PG8_SCHED;
            PG8_STAGE(PG8_SB(1, 1), b3 + hstep, voffB);
            PG8_WAIT_V(6); PG8_BAR; PG8_MMA(1, 1, At, B1); PG8_BAR;
            }
        }
        if constexpr (ALIGN_EPI) { if (wr == 0) PG8_BAR; }
        if constexpr (!Epi::AFTER_DRAIN) { E(acc, cur, wr, wc, fr, fq); S.done(cur); }
        if (!has_next) break;
#pragma unroll
        for (int a = 0; a < 2; ++a)
#pragma unroll
            for (int b = 0; b < 2; ++b)
#pragma unroll
                for (int m = 0; m < 4; ++m)
#pragma unroll
                    for (int n = 0; n < 2; ++n) acc[a][b][m][n] = (f32x4){0.f, 0.f, 0.f, 0.f};
        cur = nxt; cA = nA; cB = nB; ++ui;
        if constexpr (ALIGN_EPI) { if (wr == 1) PG8_BAR; }
    }
    PG8_WAIT_V(0);
    if constexpr (!ALIGN_EPI) { if (wr == 0) PG8_BAR; }
    PG8_BAR;
    if constexpr (Epi::AFTER_DRAIN) { E.fused(acc, cur, wr, wc, fr, fq, lds, wid, lane); S.done(cur); }
#undef PG8_SA
#undef PG8_SB
#undef PG8_STAGE
#undef PG8_LDA
#undef PG8_LDB
#undef PG8_MMA
#undef PG8_WAIT_V
#undef PG8_WAIT_L
#undef PG8_BAR
#undef PG8_SCHED
}
}

constexpr int NWAVES = 8;
constexpr int BATCH = 4, SEQ = 4096, D = 4096, M = BATCH * SEQ, FF = 4 * D;
constexpr int NZ = 2 * D;
constexpr int HEADS = 8, DK = 256, DV = 512, CH = 128, NCH = SEQ / CH;
constexpr int NP = 2 * HEADS * DK + 2 * HEADS * DV;
constexpr int ML_IN = NP + 2 * HEADS;
constexpr float EPS = 1e-6f;
constexpr float GATE_CAP = 15.0f;
#ifndef MK_N_LAUNCHES
#define MK_N_LAUNCHES 1
#endif
constexpr int N_PHASES = 13;

constexpr size_t MiB = 1u << 20;
constexpr size_t WS_CTL = 0, CTL_ZERO_BYTES = 1 * MiB;
constexpr size_t WS_VSTAT = 1 * MiB;
constexpr size_t WS_HSTAT = 9 * MiB;
constexpr size_t WS_HSSTAT = 13 * MiB;
constexpr size_t WS_GATES = 17 * MiB;
constexpr size_t WS_W1 = 32 * MiB;
constexpr size_t WS_W2 = 96 * MiB;
constexpr size_t WS_WUP0 = 128 * MiB;
constexpr size_t WS_WDN0 = 256 * MiB;
constexpr size_t WS_WML = 384 * MiB;
constexpr size_t WS_WMO = 481 * MiB;
constexpr size_t WS_WUP1 = 513 * MiB;
constexpr size_t WS_WDN1 = 641 * MiB;
constexpr size_t WS_HB = 769 * MiB;
constexpr size_t WS_R = 897 * MiB;
constexpr size_t WS_XB = WS_R, WS_Z = WS_R + 128 * MiB, WS_GATED = WS_R + 384 * MiB;
constexpr size_t WS_A = WS_R;
constexpr size_t WS_PROJ = WS_R, WS_HS = WS_R + 384 * MiB;
constexpr size_t WS_END = WS_R + 512 * MiB;
static_assert(WS_WML + (size_t)ML_IN * D * 2 <= WS_WMO, "ws map");
constexpr int CW_BAR = 4096;

constexpr int RING_BYTES = 131072;
constexpr int RS_OFF = RING_BYTES;
constexpr int LDS_BYTES = 147456;
constexpr int MISC_OFF = LDS_BYTES - 256;

#define LAS __attribute__((address_space(3)))
typedef unsigned short bf16;
typedef unsigned v4u __attribute__((ext_vector_type(4)));
typedef unsigned v2u __attribute__((ext_vector_type(2)));
typedef float f32x4 __attribute__((ext_vector_type(4)));
typedef float f32x2 __attribute__((ext_vector_type(2)));
typedef short bf16x8 __attribute__((ext_vector_type(8)));
typedef short s16x4 __attribute__((ext_vector_type(4)));
#define LDS_WAIT() asm volatile("s_waitcnt lgkmcnt(0)" ::: "memory")
__device__ __forceinline__ unsigned f2bf(float f) { unsigned u = __builtin_bit_cast(unsigned, f); return (u + 0x7fffu + ((u >> 16) & 1u)) >> 16; }
__device__ __forceinline__ unsigned pk2(float lo, float hi) { return pg8::cvt_pk_bf16(lo, hi); }
__device__ __forceinline__ unsigned pk2n(float lo, float hi) { return pg8::cvt_pk_bf16_native(lo, hi); }
__device__ __forceinline__ float bf_lo(unsigned u) { return __builtin_bit_cast(float, u << 16); }
__device__ __forceinline__ float bf_hi(unsigned u) { return __builtin_bit_cast(float, u & 0xffff0000u); }
__device__ __forceinline__ float wave_sum(float v) {
#pragma unroll
    for (int o = 1; o < 64; o <<= 1) v += __shfl_xor(v, o);
    return v;
}
#define XB_TMO      128
#define XB_XCNT(j)  (256  + 64 * (j))
#define XB_XSUB(j)  (1280 + 64 * (j))
#define XB_XGEN(j)  (2304 + 64 * (j))
#define XB_TOP      3328
#define XB_TOPGEN   3392
#define XCD_BAR_WORDS 3456
#define XB_SPIN_CAP (1u << 18)

__device__ __forceinline__ unsigned xb_ld(unsigned* p)              { return __hip_atomic_load(p, __ATOMIC_RELAXED, __HIP_MEMORY_SCOPE_AGENT); }
__device__ __forceinline__ unsigned xb_add(unsigned* p, unsigned v) { return __hip_atomic_fetch_add(p, v, __ATOMIC_RELAXED, __HIP_MEMORY_SCOPE_AGENT); }
__device__ __forceinline__ unsigned xb_xcc_id() { return (unsigned)__builtin_amdgcn_s_getreg((3 << 11) | 20) & 0xFu; }
#define XB_SPIN(cond, bar) do { unsigned _sp = 0; while (cond) { __builtin_amdgcn_s_sleep(1); \
    if ((++_sp & 255u) == 0u) { if (xb_ld(&(bar)[XB_TMO])) break; if (_sp > XB_SPIN_CAP) { atomicAdd(&(bar)[XB_TMO], 1u); break; } } } } while (0)

struct XcdBarrier {
    unsigned* bar; unsigned x;
    volatile LAS unsigned* st;
};

__device__ __forceinline__ XcdBarrier xcd_barrier_post(unsigned* bar, volatile LAS unsigned* st) {
    XcdBarrier b; b.bar = bar; b.x = xb_xcc_id(); b.st = st;
    if (threadIdx.x == 0) (void)xb_add(&bar[XB_XCNT(b.x)], 1u);
    return b;
}
__device__ __forceinline__ void xcd_barrier_complete(unsigned* bar, unsigned x, unsigned& nloc, unsigned& nx) {
    const unsigned G = gridDim.x * gridDim.y * gridDim.z;
    unsigned sum, cnt, mine, sp = 0u;
    for (;;) {
        sum = 0u; cnt = 0u; mine = 0u;
#pragma unroll
        for (unsigned j = 0; j < 16; ++j) { const unsigned c = xb_ld(&bar[XB_XCNT(j)]); sum += c; cnt += (c > 0u) ? 1u : 0u; mine = (j == x) ? c : mine; }
        if (sum == G) break;
        __builtin_amdgcn_s_sleep(1);
        if ((++sp & 255u) == 0u) { if (xb_ld(&bar[XB_TMO])) break; if (sp > XB_SPIN_CAP) { atomicAdd(&bar[XB_TMO], 1u); break; } }
    }
    nloc = mine > 0u ? mine : 1u; nx = cnt > 0u ? cnt : 1u;
}

__device__ __forceinline__ void xcd_barrier(const XcdBarrier& b) {
    asm volatile("s_waitcnt vmcnt(0)" ::: "memory");
    __syncthreads();
    if (threadIdx.x == 0) {
        unsigned* bar = b.bar;
        __builtin_amdgcn_s_waitcnt(0);
        unsigned nloc = b.st[0], nx = b.st[1];
        if (nloc == 0u) { xcd_barrier_complete(bar, b.x, nloc, nx); b.st[0] = nloc; b.st[1] = nx; }
        const unsigned old = xb_add(&bar[XB_XSUB(b.x)], 1u);
        const unsigned gen = old / nloc;
        if (old + 1u == (gen + 1u) * nloc) {
            __builtin_amdgcn_fence(__ATOMIC_RELEASE, "agent");
            asm volatile("s_waitcnt vmcnt(0)" ::: "memory");
            const unsigned og = xb_add(&bar[XB_TOP], 1u);
            const unsigned tg = og / nx;
            if (og + 1u == (tg + 1u) * nx) xb_add(&bar[XB_TOPGEN], 1u);
            else XB_SPIN(xb_ld(&bar[XB_TOPGEN]) == tg, bar);
            __builtin_amdgcn_fence(__ATOMIC_ACQUIRE, "agent");
            xb_add(&bar[XB_XGEN(b.x)], 1u);
            asm volatile("s_waitcnt vmcnt(0)" ::: "memory");
        } else {
            XB_SPIN(xb_ld(&bar[XB_XGEN(b.x)]) == gen, bar);
            __builtin_amdgcn_fence(__ATOMIC_ACQUIRE, "agent");
            asm volatile("s_waitcnt vmcnt(0)" ::: "memory");
        }
    }
    __syncthreads();
}

__device__ __forceinline__ void p0_transpose_item(const float* __restrict__ W, int Nsrc, int K, int k0, int n0, int ncols, const float* __restrict__ gk, float cs,
                                                  bf16* __restrict__ WT, LAS float* scr, int lane) {
    const int nq = lane & 15, kh = lane >> 4;
    const bool okc = 4 * nq < ncols;
    f32x4 v[16];
    const float* src = W + (size_t)(k0 + kh) * Nsrc + n0 + 4 * nq;
#pragma unroll
    for (int i = 0; i < 16; ++i) v[i] = okc ? __builtin_nontemporal_load((const f32x4*)(src + (size_t)(4 * i) * Nsrc)) : (f32x4){0.f, 0.f, 0.f, 0.f};
    const int c = lane & 7;
    f32x4 g0 = {cs, cs, cs, cs}, g1 = {cs, cs, cs, cs};
    if (gk) { g0 = *(const f32x4*)(gk + k0 + 8 * c) * cs; g1 = *(const f32x4*)(gk + k0 + 8 * c + 4) * cs; }
#pragma unroll
    for (int i = 0; i < 16; ++i) { const int kk = 4 * i + kh; *(LAS f32x4*)(scr + kk * 64 + ((4 * nq) ^ (4 * ((kk >> 3) & 7)))) = v[i]; }
    LDS_WAIT(); asm volatile("" ::: "memory");
#pragma unroll
    for (int j = 0; j < 8; ++j) { const int n = (lane >> 3) + 8 * j; const LAS float* sp = scr + (8 * c) * 64 + (n ^ (4 * c));
        v4u o; o.x = pk2(sp[0 * 64] * g0.x, sp[1 * 64] * g0.y); o.y = pk2(sp[2 * 64] * g0.z, sp[3 * 64] * g0.w); o.z = pk2(sp[4 * 64] * g1.x, sp[5 * 64] * g1.y); o.w = pk2(sp[6 * 64] * g1.z, sp[7 * 64] * g1.w);
        if (n < ncols) *(v4u*)(WT + (size_t)(n0 + n) * K + k0 + 8 * c) = o; }
    LDS_WAIT(); asm volatile("" ::: "memory");
}
struct WConv { const float* W; const float* gk; bf16* WT; int K, Nsrc; };
__device__ __forceinline__ void p0_convert(const WConv& w, int item, LAS float* scr, int lane, int qcols) {
    const int nnb = (w.Nsrc + 63) / 64, kb = item / nnb, nb = item - kb * nnb, n0 = nb * 64;
    const int ncols = (w.Nsrc - n0) < 64 ? (w.Nsrc - n0) : 64;
    p0_transpose_item(w.W, w.Nsrc, w.K, kb * 64, n0, ncols, w.gk, n0 < qcols ? 0.0625f : 1.0f, w.WT, scr, lane);
}
__device__ __forceinline__ void p0_xrow(const float* __restrict__ xrow, const float* __restrict__ g, bf16* __restrict__ orow, int lane) {
    const f32x4* xr = (const f32x4*)xrow + lane; const f32x4* gr = (const f32x4*)g + lane;
    f32x4 v[16]; float s = 0.f;
#pragma unroll
    for (int j = 0; j < 16; ++j) { v[j] = __builtin_nontemporal_load(xr + 64 * j); s += (v[j].x * v[j].x + v[j].y * v[j].y) + (v[j].z * v[j].z + v[j].w * v[j].w); }
    const float rstd = 1.0f / sqrtf(wave_sum(s) * (1.f / D) + EPS);
    v2u* o8 = (v2u*)orow + lane;
#pragma unroll
    for (int j = 0; j < 16; ++j) { const f32x4 gg = gr[64 * j]; v2u o; o.x = pk2(v[j].x * rstd * gg.x, v[j].y * rstd * gg.y); o.y = pk2(v[j].z * rstd * gg.z, v[j].w * rstd * gg.w); o8[64 * j] = o; }
}

__device__ __forceinline__ void load_rstd_table(LAS float* rs, const float* __restrict__ hstat, int pm, int tid) {
    const int row = tid >> 1, half = tid & 1;
    const f32x4* p = (const f32x4*)(hstat + ((size_t)(pm * 256 + row) * 64 + half * 32));
    float s = 0.f;
#pragma unroll
    for (int j = 0; j < 8; ++j) { const f32x4 v = p[j]; s += (v.x + v.y) + (v.z + v.w); }
    s += __shfl_xor(s, 1);
    if (half == 0) rs[row] = 1.0f / sqrtf(s * (1.f / D) + EPS);
    LDS_WAIT(); __syncthreads();
}

__device__ __forceinline__ void load_head_table(LAS float* hsc, const float* __restrict__ hsstat, int pm, int tid) {
    if (tid < 256) { const f32x4* p = (const f32x4*)(hsstat + (size_t)(pm * 256 + tid) * 64);
        float rstd[8];
#pragma unroll
        for (int h = 0; h < 8; ++h) { const f32x4 s0 = p[2 * h], s1 = p[2 * h + 1]; rstd[h] = 1.0f / sqrtf((((s0.x + s0.y) + (s0.z + s0.w)) + ((s1.x + s1.y) + (s1.z + s1.w))) * (1.f / DV) + EPS); }
        f32x4 o0 = {rstd[7], rstd[0] / rstd[1], rstd[1] / rstd[2], rstd[2] / rstd[3]}, o1 = {rstd[3] / rstd[4], rstd[4] / rstd[5], rstd[5] / rstd[6], rstd[6] / rstd[7]};
        *(LAS f32x4*)(hsc + tid * 8) = o0; *(LAS f32x4*)(hsc + tid * 8 + 4) = o1; }
    LDS_WAIT(); __syncthreads();
}

__device__ __forceinline__ int img_off(int row, int ch) { return 256 * row + 16 * (ch ^ (((row & 3) << 2) | ((row >> 2) & 3))); }
__device__ __forceinline__ void p2_spatial(LAS unsigned char* lds, const bf16* __restrict__ z, const f32x2* __restrict__ vstat, const float* __restrict__ lng, const float* __restrict__ lnb,
                                           const float* __restrict__ ws_, const float* __restrict__ bs_, bf16* __restrict__ gated, int c, int tid0) {
    LAS unsigned char* Wimg = lds;
    LAS unsigned char* Vimg = lds + 32768;
    LAS float* mu = (LAS float*)(lds + 131072);
    LAS float* rsd = mu + 256;
    const int pm = ((c & 7) << 3) | ((c >> 3) & 7), sub = c >> 6;
    const int w = __builtin_amdgcn_readfirstlane(tid0 >> 6), jq = w & 3, th = w >> 2;
    __syncthreads();
    { const int row = tid0 >> 1, part = tid0 & 1;
      const f32x4* p = (const f32x4*)(vstat + ((size_t)(pm * 256 + row) * 64 + part * 32));
      float s1 = 0.f, s2 = 0.f;
#pragma unroll
      for (int j = 0; j < 16; ++j) { const f32x4 v = p[j]; s1 += v.x + v.z; s2 += v.y + v.w; }
      s1 += __shfl_xor(s1, 1); s2 += __shfl_xor(s2, 1);
      const float mean = s1 * (1.f / D); const float var = fmaxf(s2 * (1.f / D) - mean * mean, 0.f);
      if (part == 0) { mu[row] = mean; rsd[row] = 1.0f / sqrtf(var + EPS); } }
    v4u raw[8];
#define P2_LOADV(STEP) do { const int hi_ = (STEP) >> 2, cc_ = ((STEP) >> 1) & 1, hf_ = (STEP) & 1; const int tp = pg8::fresh_tid(); \
        const bf16* vp_ = z + (size_t)(pm * 256 + cc_ * 128 + (tp >> 5)) * NZ + D + (2 * sub + hi_) * 512 + hf_ * 256 + 8 * (tp & 31); \
        _Pragma("unroll") for (int it = 0; it < 8; ++it) raw[it] = *(const v4u*)(vp_ + (size_t)(16 * it) * NZ); } while (0)
    P2_LOADV(0);
    for (int step = 0; step < 8; ++step) {
        const int hi = step >> 2, cc = (step >> 1) & 1, hf = step & 1, hh = 2 * sub + hi;
        const int m0 = pm * 256 + cc * 128, j0 = hh * 512 + hf * 256;
        __syncthreads();
        if ((step & 3) == 0) { const int tid = pg8::fresh_tid();
#pragma unroll
          for (int it = 0; it < 4; ++it) { const int p = tid + 512 * it, t = p >> 4, ch = p & 15, s0 = 8 * ch;
              const f32x4 a = *(const f32x4*)(ws_ + ((size_t)hh * 128 + t) * 128 + s0), b = *(const f32x4*)(ws_ + ((size_t)hh * 128 + t) * 128 + s0 + 4);
              v4u o; o.x = pk2(s0 + 0 <= t ? a.x : 0.f, s0 + 1 <= t ? a.y : 0.f); o.y = pk2(s0 + 2 <= t ? a.z : 0.f, s0 + 3 <= t ? a.w : 0.f);
              o.z = pk2(s0 + 4 <= t ? b.x : 0.f, s0 + 5 <= t ? b.y : 0.f); o.w = pk2(s0 + 6 <= t ? b.z : 0.f, s0 + 7 <= t ? b.w : 0.f);
              *(LAS v4u*)(Wimg + img_off(t, ch)) = o; } }
        { const int tid = pg8::fresh_tid();
          const int cg = tid & 31; float g8[8], b8[8];
          { const f32x4 a = *(const f32x4*)(lng + j0 + 8 * cg), b = *(const f32x4*)(lng + j0 + 8 * cg + 4); g8[0] = a.x; g8[1] = a.y; g8[2] = a.z; g8[3] = a.w; g8[4] = b.x; g8[5] = b.y; g8[6] = b.z; g8[7] = b.w; }
          { const f32x4 a = *(const f32x4*)(lnb + j0 + 8 * cg), b = *(const f32x4*)(lnb + j0 + 8 * cg + 4); b8[0] = a.x; b8[1] = a.y; b8[2] = a.z; b8[3] = a.w; b8[4] = b.x; b8[5] = b.y; b8[6] = b.z; b8[7] = b.w; }
#pragma unroll
          for (int it = 0; it < 8; ++it) { const int sr = (tid >> 5) + 16 * it; const float mm = mu[cc * 128 + sr], rr = rsd[cc * 128 + sr];
              float f[8] = {bf_lo(raw[it].x), bf_hi(raw[it].x), bf_lo(raw[it].y), bf_hi(raw[it].y), bf_lo(raw[it].z), bf_hi(raw[it].z), bf_lo(raw[it].w), bf_hi(raw[it].w)};
#pragma unroll
              for (int e = 0; e < 8; ++e) f[e] = (f[e] - mm) * rr * g8[e] + b8[e];
              v4u o; o.x = pk2(f[0], f[1]); o.y = pk2(f[2], f[3]); o.z = pk2(f[4], f[5]); o.w = pk2(f[6], f[7]);
              *(LAS v4u*)(Vimg + ((cg >> 4) << 15) + img_off(sr, cg & 15)) = o; } }
        LDS_WAIT(); __syncthreads();
        if (step + 1 < 8) P2_LOADV(step + 1);
        const int tid = pg8::fresh_tid(), lane = tid & 63, l15 = lane & 15, q = lane >> 4;
        const int nks = 2 * th + 2;
        v2u uu[4][4]; float bsv[4];
#pragma unroll
        for (int tbq = 0; tbq < 4; ++tbq) { const int t = 16 * (4 * th + tbq) + l15; bsv[tbq] = bs_[hh * 128 + t];
#pragma unroll
            for (int jb = 0; jb < 4; ++jb) uu[jb][tbq] = *(const v2u*)(z + (size_t)(m0 + t) * NZ + j0 + 64 * jq + 16 * jb + 4 * q); }
#pragma unroll
        for (int jb = 0; jb < 4; ++jb) {
            const int jbl = 4 * jq + jb, cI = jbl & 7; const LAS unsigned char* vb = Vimg + ((jbl >> 3) << 15);
            bf16x8 Af[4];
#pragma unroll
            for (int ks = 0; ks < 4; ++ks) { if (ks < nks) {
                const int r0 = 32 * ks + 8 * q + (l15 >> 2), c8 = 2 * cI + ((l15 & 3) >> 1);
                const s16x4 t0 = __builtin_amdgcn_ds_read_tr16_b64_v4i16((LAS s16x4*)(vb + img_off(r0, c8) + 8 * (l15 & 1)));
                const s16x4 t1 = __builtin_amdgcn_ds_read_tr16_b64_v4i16((LAS s16x4*)(vb + img_off(r0 + 4, c8) + 8 * (l15 & 1)));
                Af[ks] = (bf16x8){t0[0], t0[1], t0[2], t0[3], t1[0], t1[1], t1[2], t1[3]}; } else Af[ks] = (bf16x8){0, 0, 0, 0, 0, 0, 0, 0}; }
#pragma unroll
            for (int tbq = 0; tbq < 4; ++tbq) {
                const int tb = 4 * th + tbq; f32x4 acc = {0.f, 0.f, 0.f, 0.f};
#pragma unroll
                for (int ks = 0; ks < 4; ++ks) if (2 * ks <= tb) { const bf16x8 bfr = *(const LAS bf16x8*)(Wimg + img_off(16 * tb + l15, 4 * ks + q));
                    acc = __builtin_amdgcn_mfma_f32_16x16x32_bf16(Af[ks], bfr, acc, 0, 0, 0); }
                const int t = 16 * tb + l15, j = j0 + 64 * jq + 16 * jb + 4 * q; const float bb = bsv[tbq]; const v2u u2 = uu[jb][tbq];
                v2u o; o.x = pk2n(bf_lo(u2.x) * (acc[0] + bb), bf_hi(u2.x) * (acc[1] + bb)); o.y = pk2n(bf_lo(u2.y) * (acc[2] + bb), bf_hi(u2.y) * (acc[3] + bb));
                *(v2u*)(gated + (size_t)(m0 + t) * D + j) = o;
            }
        }
    }
#undef P2_LOADV
}

__device__ __forceinline__ void p6_gates(const bf16* __restrict__ hb, const bf16* __restrict__ wg, const LAS float* rs, float* __restrict__ gates, int c, int wave, int lane) {
    if (wave >= 4) return;
    const int pm = ((c & 7) << 3) | ((c >> 3) & 7), sub = c >> 6;
    const int rl0 = 64 * sub + 16 * wave, l15 = lane & 15, q = lane >> 4;
    const bf16* ap = hb + (size_t)(pm * 256 + rl0 + l15) * D + 8 * q;
    const bf16* bp = wg + (size_t)l15 * D + 8 * q;
    f32x4 acc0 = {0.f, 0.f, 0.f, 0.f}, acc1 = {0.f, 0.f, 0.f, 0.f};
#pragma unroll 4
    for (int ks = 0; ks < D / 32; ks += 2) {
        const bf16x8 a0 = *(const bf16x8*)(ap + 32 * ks), b0 = *(const bf16x8*)(bp + 32 * ks);
        const bf16x8 a1 = *(const bf16x8*)(ap + 32 * ks + 32), b1 = *(const bf16x8*)(bp + 32 * ks + 32);
        acc0 = __builtin_amdgcn_mfma_f32_16x16x32_bf16(a0, b0, acc0, 0, 0, 0);
        acc1 = __builtin_amdgcn_mfma_f32_16x16x32_bf16(a1, b1, acc1, 0, 0, 0);
    }
#pragma unroll
    for (int r = 0; r < 4; ++r) { const int rl = rl0 + 4 * q + r; gates[(size_t)(pm * 256 + rl) * 16 + l15] = (acc0[r] + acc1[r]) * rs[rl]; }
}

constexpr int P7_KS = 528, P7_VS = 272, P7_K_OFF = 0, P7_VT_OFF = 65536, P7_CT_OFF = P7_VT_OFF + 80 * P7_VS, P7_VEC_OFF = P7_CT_OFF + 80 * P7_KS;
__device__ __forceinline__ int p7_koff(int row, int dk8  ) { const int ch = dk8 & 15; return ((dk8 >> 4) << 15) + 256 * row + 16 * (ch ^ (((row & 3) << 2) | ((row >> 2) & 3))); }
static_assert(P7_VEC_OFF + 4096 <= MISC_OFF && P7_VT_OFF % 16 == 0 && P7_CT_OFF % 16 == 0 && P7_VEC_OFF % 16 == 0, "P7 LDS map");
template <int ABL = 0> __device__ __forceinline__ void p7_mlstm(LAS unsigned char* lds, const bf16* __restrict__ proj, const float* __restrict__ gates, const float* __restrict__ bgate,
                                         bf16* __restrict__ hs, float* __restrict__ hsstat, float* __restrict__ gsc  , int c, int tid0) {
    const int w = __builtin_amdgcn_readfirstlane(tid0 >> 6);
    const int tb = w < 4 ? w : 11 - w;
    const int xcd = c & 7, y = c >> 3, bh = 8 * (y >> 3) + xcd, sl = y & 7, b = bh >> 3, h = bh & 7;
    LAS unsigned char* Kl = lds + P7_K_OFF; LAS unsigned char* VT = lds + P7_VT_OFF; LAS unsigned char* CT = lds + P7_CT_OFF;
    LAS float* ve = (LAS float*)(lds + P7_VEC_OFF);
    LAS float* vM = ve + 128, *viw = ve + 256, *vfl = ve + 384, *vw = ve + 512, *vsc = ve + 640;
    __syncthreads();
    for (int i = tid0; i < 80 * P7_KS / 4; i += 512) ((LAS unsigned*)CT)[i] = 0u;
    for (int i = tid0; i < 16 * P7_VS / 4; i += 512) ((LAS unsigned*)(VT + 64 * P7_VS))[i] = (i < P7_VS / 4) ? 0x3f803f80u : 0u;
    { const float bi = bgate[h], bfg = bgate[8 + h]; const int lane = tid0 & 63, t0 = 2 * lane;
      for (int ch = w; ch < NCH; ch += 8) { const int m0 = b * SEQ + ch * CH;
          float ip[2], lf[2];
#pragma unroll
          for (int k = 0; k < 2; ++k) { const float gi = gates[(size_t)(m0 + t0 + k) * 16 + h] + bi, gf = gates[(size_t)(m0 + t0 + k) * 16 + 8 + h] + bfg;
              ip[k] = GATE_CAP * tanhf(gi * (1.f / GATE_CAP)); const float fp = GATE_CAP * tanhf(gf * (1.f / GATE_CAP));
              lf[k] = fminf(fp, 0.f) - log1pf(expf(-fabsf(fp))); }
          const float pair = lf[0] + lf[1]; float inc = pair;
#pragma unroll
          for (int o = 1; o < 64; o <<= 1) { const float n = __shfl_up(inc, o); if (lane >= o) inc += n; }
          const float bc0 = (inc - pair) + lf[0], bc1 = inc;
          const float e0 = ip[0] - bc0, e1 = ip[1] - bc1;
          float im = fmaxf(e0, e1);
#pragma unroll
          for (int o = 1; o < 64; o <<= 1) { const float n = __shfl_up(im, o); if (lane >= o) im = fmaxf(im, n); }
          float ex = __shfl_up(im, 1); if (lane == 0) ex = -3.0e38f;
          f32x2* g2 = (f32x2*)(gsc + ch * 384) + lane;
          g2[0] = (f32x2){bc0, bc1}; g2[64] = (f32x2){e0, e1}; g2[128] = (f32x2){fmaxf(ex, e0), im}; } }
    f32x4 accC[2][5];
#pragma unroll
    for (int a = 0; a < 2; ++a)
#pragma unroll
        for (int d = 0; d < 5; ++d) accC[a][d] = (f32x4){0.f, 0.f, 0.f, 0.f};
    float mcar = 0.f;
    v4u idw[2];
#pragma unroll
    for (int kb = 0; kb < 2; ++kb) { const int tgt = 16 * kb + (tid0 & 15) - 8 * ((tid0 & 63) >> 4);
        idw[kb].x = (tgt == 0 ? 0x3f80u : 0u) | (tgt == 1 ? 0x3f800000u : 0u); idw[kb].y = (tgt == 2 ? 0x3f80u : 0u) | (tgt == 3 ? 0x3f800000u : 0u);
        idw[kb].z = (tgt == 4 ? 0x3f80u : 0u) | (tgt == 5 ? 0x3f800000u : 0u); idw[kb].w = (tgt == 6 ? 0x3f80u : 0u) | (tgt == 7 ? 0x3f800000u : 0u); }
    asm volatile("s_waitcnt vmcnt(0)" ::: "memory"); __syncthreads();
    v4u kr[8], vr[2]; bf16x8 Qf[8]; f32x2 gv[3];
#define P7_PREFETCH(CHN) do { const int m0n = b * SEQ + (CHN) * CH; const int tidp = pg8::fresh_tid(), lp = tidp & 63; \
        _Pragma("unroll") for (int it = 0; it < 8; ++it) { const int p = tidp + 512 * it, row = p >> 5, c16 = p & 31; kr[it] = *(const v4u*)(proj + (size_t)(m0n + row) * NP + 2048 + h * DK + 8 * c16); } \
        _Pragma("unroll") for (int it = 0; it < 2; ++it) { const int p = tidp + 512 * it, sidx = p & 127, cg = p >> 7; vr[it] = *(const v4u*)(proj + (size_t)(m0n + sidx) * NP + 4096 + h * DV + sl * 64 + 8 * cg); } \
        { const bf16* qp = proj + (size_t)(m0n + 16 * tb + (lp & 15)) * NP + h * DK + 8 * (lp >> 4); _Pragma("unroll") for (int ks = 0; ks < 8; ++ks) Qf[ks] = *(const bf16x8*)(qp + 32 * ks); } \
        { const f32x2* g2 = (const f32x2*)(gsc + (CHN) * 384) + lp; gv[0] = g2[0]; gv[1] = g2[64]; gv[2] = g2[128]; } } while (0)
    P7_PREFETCH(0);
    for (int ch = 0; ch < NCH; ++ch) {
        const int m0 = b * SEQ + ch * CH;
        const int tid = pg8::fresh_tid(), lane = tid & 63, l15 = lane & 15, q = lane >> 4;
        const int fsw = ((l15 & 3) << 2) | ((l15 >> 2) & 3);
        {
            const int t0 = 2 * lane;
            const float M0 = fmaxf(mcar, gv[2].x), M1 = fmaxf(mcar, gv[2].y);
            const float Ml = __shfl(M1, 63), gl = __shfl(gv[0].y, 63);
            if (w == 0) {
                *(LAS f32x2*)(ve + t0) = gv[1]; *(LAS f32x2*)(vM + t0) = (f32x2){M0, M1};
                *(LAS f32x2*)(viw + t0) = (f32x2){__expf(mcar - M0), __expf(mcar - M1)};
                *(LAS f32x2*)(vfl + t0) = (f32x2){__expf(-gv[0].x - M0), __expf(-gv[0].y - M1)};
                *(LAS f32x2*)(vw + t0) = (f32x2){__expf(gv[1].x - Ml), __expf(gv[1].y - Ml)};
                if (lane == 0) vsc[0] = __expf(mcar - Ml); }
            mcar = gl + Ml; }
#pragma unroll
        for (int it = 0; it < 8; ++it) { const int row0 = tid >> 5, c16 = tid & 31; *(LAS v4u*)(Kl + p7_koff(row0, c16) + 4096 * it) = kr[it]; }
#pragma unroll
        for (int it = 0; it < 2; ++it) { const int p = tid + 512 * it, sidx = p & 127, cg = p >> 7; const v4u v = vr[it];
            LAS bf16* d = (LAS bf16*)(VT + (8 * cg) * P7_VS) + sidx;
            d[0 * (P7_VS / 2)] = (bf16)(v.x & 0xffffu); d[1 * (P7_VS / 2)] = (bf16)(v.x >> 16); d[2 * (P7_VS / 2)] = (bf16)(v.y & 0xffffu); d[3 * (P7_VS / 2)] = (bf16)(v.y >> 16);
            d[4 * (P7_VS / 2)] = (bf16)(v.z & 0xffffu); d[5 * (P7_VS / 2)] = (bf16)(v.z >> 16); d[6 * (P7_VS / 2)] = (bf16)(v.w & 0xffffu); d[7 * (P7_VS / 2)] = (bf16)(v.w >> 16); }
        LDS_WAIT(); __syncthreads();
        f32x4 accS[8];
        { bf16x8 kfb[2][4];
          const int kbase = 256 * l15 + 16 * (q ^ fsw);
#define P7_KF(js_, ks_) (*(const LAS bf16x8*)(Kl + 256 * l15 + 16 * ((4 * ((ks_) & 3) + q) ^ fsw) + (((ks_) >> 2) << 15) + 4096 * (js_)))
          (void)kbase;
#pragma unroll
          for (int ks = 0; ks < 4; ++ks) kfb[0][ks] = P7_KF(0, ks);
#pragma unroll
          for (int g = 0; g < 16; ++g) { const int js = g >> 1, hf = g & 1;
              if (hf == 0) accS[js] = (f32x4){0.f, 0.f, 0.f, 0.f};
              if (js <= tb && !(ABL & 1)) {
                  if (g + 1 < 16 && ((g + 1) >> 1) <= tb) {
#pragma unroll
                      for (int ks = 0; ks < 4; ++ks) kfb[(g + 1) & 1][ks] = P7_KF((g + 1) >> 1, 4 * ((g + 1) & 1) + ks); }
                  __builtin_amdgcn_sched_barrier(0);
#pragma unroll
                  for (int ks = 0; ks < 4; ++ks) accS[js] = __builtin_amdgcn_mfma_f32_16x16x32_bf16(kfb[g & 1][ks], Qf[4 * hf + ks], accS[js], 0, 0, 0);
                  __builtin_amdgcn_sched_barrier(0); } }
#undef P7_KF
        }
        const int tl = 16 * tb + l15; const float Mt = vM[tl], iwt = viw[tl], flt = vfl[tl];
        unsigned pk[8][2];
#pragma unroll
        for (int js = 0; js < 8; ++js) { if constexpr (ABL & 16) { pk[js][0] = 0u; pk[js][1] = 0u; continue; } const f32x4 ev = *(const LAS f32x4*)(ve + 16 * js + 4 * q); const int s0 = 16 * js + 4 * q;
            const float p0 = (s0 + 0 <= tl) ? accS[js][0] * __expf(ev.x - Mt) : 0.f, p1 = (s0 + 1 <= tl) ? accS[js][1] * __expf(ev.y - Mt) : 0.f;
            const float p2 = (s0 + 2 <= tl) ? accS[js][2] * __expf(ev.z - Mt) : 0.f, p3 = (s0 + 3 <= tl) ? accS[js][3] * __expf(ev.w - Mt) : 0.f;
            pk[js][0] = pk2n(p0, p1); pk[js][1] = pk2n(p2, p3); }
        v2u og[4];
        { const bf16* gp = proj + (size_t)(m0 + tl) * NP + 8192 + h * DV + sl * 64 + 4 * q;
#pragma unroll
          for (int d = 0; d < 4; ++d) og[d] = *(const v2u*)(gp + 16 * d); }
        f32x4 acc3[5], acc4[5];
#pragma unroll
        for (int d = 0; d < 5; ++d) { acc3[d] = (f32x4){0.f, 0.f, 0.f, 0.f}; acc4[d] = (f32x4){0.f, 0.f, 0.f, 0.f}; }
#pragma unroll
        for (int a = 0; a < 4; ++a) if (2 * a <= tb && !(ABL & 1)) {
            const v4u pu = {pk[2 * a][0], pk[2 * a][1], pk[2 * a + 1][0], pk[2 * a + 1][1]}; const bf16x8 pf = __builtin_bit_cast(bf16x8, pu);
#pragma unroll
            for (int d = 0; d < 5; ++d) { const LAS unsigned char* vp = VT + (16 * d + l15) * P7_VS + 64 * a + 8 * q;
                const v2u lo = *(const LAS v2u*)vp, hi = *(const LAS v2u*)(vp + 32); const v4u vu = {lo.x, lo.y, hi.x, hi.y};
                acc3[d] = __builtin_amdgcn_mfma_f32_16x16x32_bf16(__builtin_bit_cast(bf16x8, vu), pf, acc3[d], 0, 0, 0); } }
        if constexpr (!(ABL & 2)) { bf16x8 cfb[2][4];
#define P7_CF(d_, ks_) (*(const LAS bf16x8*)(CT + (16 * (d_) + l15) * P7_KS + 64 * (ks_) + 16 * q))
#pragma unroll
          for (int ks = 0; ks < 4; ++ks) cfb[0][ks] = P7_CF(0, ks);
#pragma unroll
          for (int g = 0; g < 10; ++g) { const int d = g >> 1, hf = g & 1;
              if (g + 1 < 10) {
#pragma unroll
                  for (int ks = 0; ks < 4; ++ks) cfb[(g + 1) & 1][ks] = P7_CF((g + 1) >> 1, 4 * ((g + 1) & 1) + ks); }
              __builtin_amdgcn_sched_barrier(0);
#pragma unroll
              for (int ks = 0; ks < 4; ++ks) acc4[d] = __builtin_amdgcn_mfma_f32_16x16x32_bf16(cfb[g & 1][ks], Qf[4 * hf + ks], acc4[d], 0, 0, 0);
              __builtin_amdgcn_sched_barrier(0); }
#undef P7_CF
        }
        { const float den = __shfl(iwt * acc4[4][0] + acc3[4][0], l15);
          const float inv = 1.0f / fmaxf(fabsf(den), flt); float ss = 0.f;
          bf16* op = hs + (size_t)(m0 + tl) * D + h * DV + sl * 64 + 4 * q;
#pragma unroll
          for (int d = 0; d < 4; ++d) { const float o0 = (iwt * acc4[d][0] + acc3[d][0]) * inv, o1 = (iwt * acc4[d][1] + acc3[d][1]) * inv, o2 = (iwt * acc4[d][2] + acc3[d][2]) * inv, o3 = (iwt * acc4[d][3] + acc3[d][3]) * inv;
              ss += (o0 * o0 + o1 * o1) + (o2 * o2 + o3 * o3);
              const float s0 = 1.0f / (1.0f + __expf(-bf_lo(og[d].x))), s1 = 1.0f / (1.0f + __expf(-bf_hi(og[d].x))), s2 = 1.0f / (1.0f + __expf(-bf_lo(og[d].y))), s3 = 1.0f / (1.0f + __expf(-bf_hi(og[d].y)));
              v2u o; o.x = pk2n(o0 * s0, o1 * s1); o.y = pk2n(o2 * s2, o3 * s3); *(v2u*)(op + 16 * d) = o; }
          ss += __shfl_xor(ss, 16); ss += __shfl_xor(ss, 32);
          if (q == 0) hsstat[(size_t)(m0 + tl) * 64 + h * 8 + sl] = ss; }
        if (ch + 1 < NCH && !(ABL & 8)) P7_PREFETCH(ch + 1);
        { const float dec = vsc[0];
#pragma unroll
          for (int a = 0; a < 2; ++a)
#pragma unroll
              for (int d = 0; d < 5; ++d) accC[a][d] = accC[a][d] * dec; }
        if constexpr (!(ABL & 4))
#pragma unroll
        for (int a = 0; a < 4; ++a) {
            const f32x4 w0 = *(const LAS f32x4*)(vw + 32 * a + 4 * q), w1 = *(const LAS f32x4*)(vw + 32 * a + 16 + 4 * q);
            bf16x8 kt[2];
            { const int krb = 256 * l15 + 16 * ((4 * (w & 3) + q) ^ fsw) + ((w >> 2) << 15);
              const bf16x8 kr0 = *(const LAS bf16x8*)(Kl + krb + 8192 * a), kr1 = *(const LAS bf16x8*)(Kl + krb + 8192 * a + 4096);
#pragma unroll
              for (int kb = 0; kb < 2; ++kb) { const bf16x8 idf = __builtin_bit_cast(bf16x8, idw[kb]);
                  const f32x4 z4 = {0.f, 0.f, 0.f, 0.f};
                  const f32x4 d0 = __builtin_amdgcn_mfma_f32_16x16x32_bf16(kr0, idf, z4, 0, 0, 0), d1 = __builtin_amdgcn_mfma_f32_16x16x32_bf16(kr1, idf, z4, 0, 0, 0);
                  const v4u ku = {pk2n(d0[0] * w0.x, d0[1] * w0.y), pk2n(d0[2] * w0.z, d0[3] * w0.w), pk2n(d1[0] * w1.x, d1[1] * w1.y), pk2n(d1[2] * w1.z, d1[3] * w1.w)}; kt[kb] = __builtin_bit_cast(bf16x8, ku); } }
#pragma unroll
            for (int d = 0; d < 5; ++d) { const LAS unsigned char* vp = VT + (16 * d + l15) * P7_VS + 64 * a + 8 * q;
                const v2u lo = *(const LAS v2u*)vp, hi = *(const LAS v2u*)(vp + 32); const v4u vu = {lo.x, lo.y, hi.x, hi.y};
                const bf16x8 vf = __builtin_bit_cast(bf16x8, vu);
                accC[0][d] = __builtin_amdgcn_mfma_f32_16x16x32_bf16(kt[0], vf, accC[0][d], 0, 0, 0);
                accC[1][d] = __builtin_amdgcn_mfma_f32_16x16x32_bf16(kt[1], vf, accC[1][d], 0, 0, 0); } }
        LDS_WAIT(); __syncthreads();
#pragma unroll
        for (int kb = 0; kb < 2; ++kb)
#pragma unroll
            for (int d = 0; d < 5; ++d) { v2u o; o.x = pk2n(accC[kb][d][0], accC[kb][d][1]); o.y = pk2n(accC[kb][d][2], accC[kb][d][3]);
                *(LAS v2u*)(CT + (16 * d + l15) * P7_KS + 2 * (16 * (2 * w + kb) + 4 * q)) = o; }
    }
#undef P7_PREFETCH
    LDS_WAIT(); __syncthreads();
}

__device__ __forceinline__ void p12_final(const bf16* __restrict__ hb, float* __restrict__ out, const float* __restrict__ hstat, const float* __restrict__ g, int c, int wave, int lane) {
    const int pm = ((c & 7) << 3) | ((c >> 3) & 7), sub = c >> 6;
    for (int i = 0; i < 8; ++i) {
        const int m = pm * 256 + sub * 64 + wave * 8 + i;
        const float sv = hstat[(size_t)m * 64 + lane];
        const float rstd = 1.0f / sqrtf(wave_sum(sv) * (1.f / D) + EPS);
        const v4u* rin = (const v4u*)(hb + (size_t)m * D) + lane; f32x4* row = (f32x4*)(out + (size_t)m * D) + 2 * lane; const f32x4* gr = (const f32x4*)g + 2 * lane;
#pragma unroll
        for (int j = 0; j < 8; ++j) { const v4u w = rin[64 * j]; const f32x4 g0 = gr[128 * j], g1 = gr[128 * j + 1];
            f32x4 v0 = {bf_lo(w.x) * rstd * g0.x, bf_hi(w.x) * rstd * g0.y, bf_lo(w.y) * rstd * g0.z, bf_hi(w.y) * rstd * g0.w};
            f32x4 v1 = {bf_lo(w.z) * rstd * g1.x, bf_hi(w.z) * rstd * g1.y, bf_lo(w.w) * rstd * g1.z, bf_hi(w.w) * rstd * g1.w};
            row[128 * j] = v0; row[128 * j + 1] = v1; }
    }
}

struct Args { const float* in[16]; float* out; unsigned char* ws; int ph_lo, ph_hi, li, pad; };
__global__ void __launch_bounds__(NWAVES * 64, 2) mk_fwd(Args args) {
    extern __shared__ __attribute__((aligned(16))) unsigned char lds_raw[];
    LAS unsigned char* lds = (LAS unsigned char*)lds_raw;
    volatile LAS unsigned* MISC = (volatile LAS unsigned*)(lds + MISC_OFF);
        const int G = gridDim.x, c = blockIdx.x;
    unsigned char* ws = args.ws;
    unsigned* ctl = (unsigned*)(ws + WS_CTL);
    const float* x = args.in[0]; const float* norm_mix = args.in[1]; const float* norm_ffn = args.in[2];
    const float* gm_w_in = args.in[3]; const float* gm_ln_g = args.in[4]; const float* gm_ln_b = args.in[5]; const float* gm_w_s = args.in[6]; const float* gm_b_s = args.in[7];
    const float* gm_w_out = args.in[8]; const float* ml_w_in = args.in[9]; const float* ml_b_gate = args.in[10]; const float* ml_head_g = args.in[11]; const float* ml_w_out = args.in[12];
    const float* ffn_w_up = args.in[13]; const float* ffn_w_down = args.in[14]; const float* norm_final = args.in[15];
    float* out = args.out;
    f32x2* vstat = (f32x2*)(ws + WS_VSTAT); float* hstat = (float*)(ws + WS_HSTAT); float* hsstat = (float*)(ws + WS_HSSTAT); float* gates = (float*)(ws + WS_GATES);
    bf16* W1 = (bf16*)(ws + WS_W1); bf16* W2 = (bf16*)(ws + WS_W2); bf16* WUP0 = (bf16*)(ws + WS_WUP0); bf16* WDN0 = (bf16*)(ws + WS_WDN0);
    bf16* WML = (bf16*)(ws + WS_WML); bf16* WMO = (bf16*)(ws + WS_WMO); bf16* WUP1 = (bf16*)(ws + WS_WUP1); bf16* WDN1 = (bf16*)(ws + WS_WDN1);
    bf16* HB = (bf16*)(ws + WS_HB); bf16* XB = (bf16*)(ws + WS_XB); bf16* Z = (bf16*)(ws + WS_Z); bf16* GATED = (bf16*)(ws + WS_GATED);
    bf16* A = (bf16*)(ws + WS_A); bf16* PROJ = (bf16*)(ws + WS_PROJ); bf16* HS = (bf16*)(ws + WS_HS);
    LAS float* rs = (LAS float*)(lds + RS_OFF);

    if (threadIdx.x < 64) MISC[threadIdx.x] = 0u;
    __syncthreads();
    XcdBarrier bar = xcd_barrier_post(ctl + CW_BAR + args.li * XCD_BAR_WORDS, MISC + 8);

    const int lo = args.ph_lo, hi = args.ph_hi;
#define IN(k) (lo <= (k) && (k) < hi)
#define TID() const int tid = pg8::fresh_tid(), lane = tid & 63, wave = __builtin_amdgcn_readfirstlane(tid >> 6); (void)lane; (void)wave;
#define SEAM(k) do { if (IN(k) && IN((k) + 1)) xcd_barrier(bar); } while (0)

    if (IN(0)) { TID();
        LAS float* scr = (LAS float*)(lds + wave * 16384);
        const int vcu = (c & 7) * (G >> 3) + (c >> 3);
        const int gw = vcu * NWAVES + wave, NGW = G * NWAVES;
        constexpr int I0 = (D / 64) * (NZ / 64), I1 = (D / 64) * (D / 64), I2 = (D / 64) * (FF / 64), I3 = (FF / 64) * (D / 64), I4 = (D / 64) * ((ML_IN + 63) / 64);
        constexpr int NITEMS = I0 + I1 + I2 + I3 + I4 + I1 + I2 + I3;
        for (int it = gw; it < NITEMS; it += NGW) {
            int r = it; WConv wc; int qcols = 0;
            if (r < I0) { wc = WConv{gm_w_in, nullptr, W1, D, NZ}; }
            else if ((r -= I0) < I1) { wc = WConv{gm_w_out, nullptr, W2, D, D}; }
            else if ((r -= I1) < I2) { wc = WConv{ffn_w_up, norm_ffn, WUP0, D, FF}; }
            else if ((r -= I2) < I3) { wc = WConv{ffn_w_down, nullptr, WDN0, FF, D}; }
            else if ((r -= I3) < I4) { wc = WConv{ml_w_in, norm_mix + D, WML, D, ML_IN}; qcols = 2048; }
            else if ((r -= I4) < I1) { wc = WConv{ml_w_out, ml_head_g, WMO, D, D}; }
            else if ((r -= I1) < I2) { wc = WConv{ffn_w_up + (size_t)D * FF, norm_ffn + D, WUP1, D, FF}; }
            else { r -= I2; wc = WConv{ffn_w_down + (size_t)FF * D, nullptr, WDN1, FF, D}; }
            p0_convert(wc, r, scr, lane, qcols);
        }
        for (int m = gw; m < M; m += NGW) p0_xrow(x + (size_t)m * D, norm_mix, XB + (size_t)m * D, lane);
    }
    SEAM(0);
    if (IN(1)) {
        pg8::Gemm g{XB, W1, M, NZ, D}; pg8::PanelOrder S; S.init(NZ, c);
        pg8::EpiGelu E{Z, NZ, (pg8::f32x2*)vstat};
        pg8::gemm_phase<pg8::EpiGelu, pg8::PanelOrder, true, true>(lds, g, S, E);
    }
    SEAM(1);
    if (IN(2)) { TID(); p2_spatial(lds, Z, vstat, gm_ln_g, gm_ln_b, gm_w_s, gm_b_s, GATED, c, tid); }
    SEAM(2);
    if (IN(3)) {
        pg8::Gemm g{GATED, W2, M, D, D}; pg8::PanelOrder S; S.init(D, c);
        pg8::EpiResid<true> E{x, HB, hstat};
        pg8::gemm_phase<pg8::EpiResid<true>, pg8::PanelOrder, true, true>(lds, g, S, E);
    }
    SEAM(3);
    if (IN(4)) { TID();
        pg8::PanelOrder S; S.init(FF, c);
        load_rstd_table(rs, hstat, S.pm, tid);
        pg8::Gemm g{HB, WUP0, M, FF, D};
        pg8::EpiScale<true> E{A, FF, rs};
        pg8::gemm_phase<pg8::EpiScale<true>, pg8::PanelOrder, true, true>(lds, g, S, E);
    }
    SEAM(4);
    if (IN(5)) {
        pg8::Gemm g{A, WDN0, M, D, FF}; pg8::PanelOrder S; S.init(D, c);
        pg8::EpiResid<false> E{nullptr, HB, hstat};
        pg8::gemm_phase<pg8::EpiResid<false>, pg8::PanelOrder, true, true>(lds, g, S, E);
    }
    SEAM(5);
    if (IN(6)) { TID();
        pg8::PanelOrder S; S.init(NP, c);
        load_rstd_table(rs, hstat, S.pm, tid);
        pg8::Gemm g{HB, WML, M, NP, D};
        pg8::EpiScale<false> E{PROJ, NP, rs};
        pg8::gemm_phase<pg8::EpiScale<false>, pg8::PanelOrder, true, true>(lds, g, S, E);
        p6_gates(HB, WML + (size_t)NP * D, rs, gates, c, wave, lane);
    }
    SEAM(6);
    if (IN(7)) { TID(); p7_mlstm(lds, PROJ, gates, ml_b_gate, HS, hsstat, (float*)(ws + WS_WUP0) + (size_t)c * (NCH * 384), c, tid); }
    do { if (IN(7) && IN(9)) xcd_barrier(bar); } while (0);
    if (IN(9)) {
        pg8::Gemm g{HS, WMO, M, D, D}; pg8::PanelOrder S; S.init(D, c);
        { TID(); load_head_table(rs, hsstat, S.pm, tid); }
        pg8::EpiResidH E{HB, hstat, rs};
        pg8::gemm_phase<pg8::EpiResidH, pg8::PanelOrder, true, true>(lds, g, S, E);
    }
    SEAM(9);
    if (IN(10)) { TID();
        pg8::PanelOrder S; S.init(FF, c);
        load_rstd_table(rs, hstat, S.pm, tid);
        pg8::Gemm g{HB, WUP1, M, FF, D};
        pg8::EpiScale<true> E{A, FF, rs};
        pg8::gemm_phase<pg8::EpiScale<true>, pg8::PanelOrder, true, true>(lds, g, S, E);
    }
    SEAM(10);
    if (IN(11)) {
        pg8::Gemm g{A, WDN1, M, D, FF}; pg8::PanelOrder S; S.init(D, c);
        pg8::EpiResid<false> E{nullptr, HB, hstat};
        pg8::gemm_phase<pg8::EpiResid<false>, pg8::PanelOrder, true, true>(lds, g, S, E);
    }
    SEAM(11);
    if (IN(12)) { TID(); p12_final(HB, out, hstat, norm_final, c, wave, lane); }
#undef IN
#undef SEAM
}

extern "C" void kernel_launch(void* const* d_in, const int* in_sizes, int n_in, void* d_out, int out_size, void* d_ws, size_t ws_size, hipStream_t stream) {
    static int grid = 0;
    if (grid == 0) {
        if (n_in != 16 || in_sizes[0] != M * D || out_size != M * D || ws_size < WS_END) {
            fprintf(stderr, "kernel_launch: unexpected shapes: n_in %d in0 %d out %d ws %zu (need %zu)\n", n_in, n_in > 0 ? in_sizes[0] : -1, out_size, ws_size, (size_t)WS_END); grid = -1; return; }
        if (hipFuncSetAttribute((const void*)mk_fwd, hipFuncAttributeMaxDynamicSharedMemorySize, LDS_BYTES) != hipSuccess) { fprintf(stderr, "kernel_launch: hipFuncSetAttribute failed\n"); grid = -1; return; }
        int per_cu = 0;
        if (hipOccupancyMaxActiveBlocksPerMultiprocessor(&per_cu, (const void*)mk_fwd, NWAVES * 64, LDS_BYTES) != hipSuccess || per_cu < 1)
            fprintf(stderr, "kernel_launch: occupancy query reports %d workgroups per CU\n", per_cu);
        (void)hipGetLastError();
        grid = 256;
    }
    if (grid < 0) return;
    if (hipMemsetAsync((char*)d_ws + WS_CTL, 0, CTL_ZERO_BYTES, stream) != hipSuccess) { fprintf(stderr, "kernel_launch: memset failed\n"); return; }
    Args a{};
    for (int i = 0; i < 16; ++i) a.in[i] = (const float*)d_in[i];
    a.out = (float*)d_out; a.ws = (unsigned char*)d_ws;
#if MK_N_LAUNCHES == 1
    a.ph_lo = 0; a.ph_hi = N_PHASES; a.li = 0;
    hipLaunchKernelGGL(mk_fwd, dim3(grid), dim3(NWAVES * 64), LDS_BYTES, stream, a);
#else
    for (int p = 0; p < N_PHASES; ++p) { a.ph_lo = p; a.ph_hi = p + 1; a.li = 0; hipLaunchKernelGGL(mk_fwd, dim3(grid), dim3(NWAVES * 64), LDS_BYTES, stream, a); }
#endif
    const hipError_t le = hipPeekAtLastError();
    if (le != hipSuccess) fprintf(stderr, "kernel_launch: launch failed: %s\n", hipGetErrorName(le));
}
```
